# Optimizing an MI355X kernel written in HIP

```python
import jax, jax.numpy as jnp
from jax import lax
import numpy as np

D_MODEL = 1024
BATCH = 4
SEQ = 4096
DEPTH = 4

N_EVEN = (DEPTH + 1) // 2
N_ODD = DEPTH // 2
EPS = 1e-6
CHUNK = 128
A_WIDTH = D_MODEL // 2
A_HEADS = 8
A_HEAD_DIM = A_WIDTH // A_HEADS
B_WIDTH = D_MODEL // 2
POOL_WINDOWS = (2, 4, 8, 16)
B_GROUPS = len(POOL_WINDOWS)
B_GROUP_DIM = B_WIDTH // B_GROUPS
IN_E = 2 * A_WIDTH + B_WIDTH
MIX_E = A_WIDTH + B_WIDTH
C_WIDTH = D_MODEL
CONV_K = 31
D_FF_DENSE = 2816
N_EXPERTS = 8
TOP_K = 2
D_FF_EXPERT = 3584

kernel_name = "hybrid_gmlp_pool_conformer_moe_trunk"


def rmsnorm(x, g):
    xf = x.astype(jnp.float32)
    y = xf * lax.rsqrt(jnp.mean(xf * xf, axis=-1, keepdims=True) + EPS)
    return (y * g.astype(jnp.float32)).astype(x.dtype)


def layernorm(x, g, b):
    xf = x.astype(jnp.float32)
    mu = jnp.mean(xf, axis=-1, keepdims=True)
    xc = xf - mu
    var = jnp.mean(xc * xc, axis=-1, keepdims=True)
    y = xc * lax.rsqrt(var + EPS) * g.astype(jnp.float32) + b.astype(jnp.float32)
    return y.astype(x.dtype)


def swiglu(h, w_gate, w_up, w_down):
    return (jax.nn.silu(h @ w_gate) * (h @ w_up)) @ w_down


def chunked_sgu(u, v, g_v, w_s, b_s):
    bsz, s, _ = v.shape
    v = rmsnorm(v, g_v)
    vc = v.reshape(bsz, s // CHUNK, CHUNK, A_HEADS, A_HEAD_DIM)
    w = jnp.tril(w_s)
    mixed = jnp.einsum('hts,bnshd->bnthd', w, vc) + b_s.T[None, None, :, :, None]
    return u * mixed.reshape(bsz, s, A_WIDTH)


def pool_mixer(z, w_pool, scale):
    bsz, s, _ = z.shape
    zg = z.astype(jnp.float32).reshape(bsz, s, B_GROUPS, B_GROUP_DIM)
    cs = jnp.cumsum(zg, axis=1)
    pos = jnp.arange(1, s + 1, dtype=jnp.float32)
    means = []
    for g, win in enumerate(POOL_WINDOWS):
        csg = cs[:, :, g]
        lag = jnp.pad(csg, ((0, 0), (win, 0), (0, 0)))[:, :s]
        cnt = jnp.minimum(pos, jnp.float32(win))
        means.append((csg - lag) / cnt[None, :, None])
    mixed = (jnp.stack(means, axis=2) - zg).astype(z.dtype)
    y = jnp.einsum('bsgc,gcd->bsgd', mixed, w_pool).reshape(bsz, s, B_WIDTH)
    return y * scale


def conformer_conv(h, w_pw1, b_pw1, w_dw, b_dw, ln_g, ln_b, w_pw2, b_pw2):
    a = h @ w_pw1 + b_pw1
    val, gate = jnp.split(a, 2, axis=-1)
    x = val * jax.nn.sigmoid(gate)
    x = lax.conv_general_dilated(
        x, w_dw[:, None, :].astype(x.dtype), window_strides=(1,),
        padding=[(CONV_K - 1, 0)], dimension_numbers=('NWC', 'WIO', 'NWC'),
        feature_group_count=C_WIDTH) + b_dw
    x = jax.nn.silu(layernorm(x, ln_g, ln_b))
    return x @ w_pw2 + b_pw2


def moe_swiglu(h, w_router, w_gate, w_up, w_down):
    bsz, s, d = h.shape
    hf = h.reshape(bsz * s, d)
    logits = (hf @ w_router).astype(jnp.float32)
    top_v, top_i = lax.top_k(logits, TOP_K)
    gates = jax.nn.softmax(top_v, axis=-1)
    comb = jnp.sum(jax.nn.one_hot(top_i, N_EXPERTS, dtype=jnp.float32) * gates[..., None], axis=1)
    comb = comb.astype(h.dtype)
    y = jnp.zeros_like(hf)
    for e in range(N_EXPERTS):
        y = y + comb[:, e:e + 1] * swiglu(hf, w_gate[e], w_up[e], w_down[e])
    return y.reshape(bsz, s, d)


def setup_inputs(seed: int = 0) -> dict:
    key = jax.random.key(seed)
    ks = iter(jax.random.split(key, 40))
    f32 = jnp.float32

    def nrm(shape, fan_in):
        return jax.random.normal(next(ks), shape, f32) * (fan_in ** -0.5)

    def gain(shape):
        return 1.0 + 0.05 * jax.random.normal(next(ks), shape, f32)

    def bias(shape):
        return 0.02 * jax.random.normal(next(ks), shape, f32)

    tri = jnp.tril(jnp.ones((CHUNK, CHUNK), f32))
    return {
        "x": jax.random.normal(next(ks), (BATCH, SEQ, D_MODEL), f32),
        "norm_mix_e": gain((N_EVEN, D_MODEL)),
        "w_in_e": nrm((N_EVEN, D_MODEL, IN_E), D_MODEL),
        "sgu_norm": gain((N_EVEN, A_WIDTH)),
        "w_spatial": nrm((N_EVEN, A_HEADS, CHUNK, CHUNK), CHUNK) * tri,
        "b_spatial": gain((N_EVEN, A_HEADS, CHUNK)),
        "w_pool": nrm((N_EVEN, B_GROUPS, B_GROUP_DIM, B_GROUP_DIM), B_GROUP_DIM),
        "pool_scale": gain((N_EVEN, B_WIDTH)),
        "w_out_e": nrm((N_EVEN, MIX_E, D_MODEL), MIX_E),
        "norm_ffn_e": gain((N_EVEN, D_MODEL)),
        "w_gate_d": nrm((N_EVEN, D_MODEL, D_FF_DENSE), D_MODEL),
        "w_up_d": nrm((N_EVEN, D_MODEL, D_FF_DENSE), D_MODEL),
        "w_down_d": nrm((N_EVEN, D_FF_DENSE, D_MODEL), D_FF_DENSE),
        "norm_mix_o": gain((N_ODD, D_MODEL)),
        "w_pw1": nrm((N_ODD, D_MODEL, 2 * C_WIDTH), D_MODEL),
        "b_pw1": bias((N_ODD, 2 * C_WIDTH)),
        "w_dw": nrm((N_ODD, CONV_K, C_WIDTH), CONV_K),
        "b_dw": bias((N_ODD, C_WIDTH)),
        "ln_g": gain((N_ODD, C_WIDTH)),
        "ln_b": bias((N_ODD, C_WIDTH)),
        "w_pw2": nrm((N_ODD, C_WIDTH, D_MODEL), C_WIDTH),
        "b_pw2": bias((N_ODD, D_MODEL)),
        "norm_ffn_o": gain((N_ODD, D_MODEL)),
        "w_router": nrm((N_ODD, D_MODEL, N_EXPERTS), D_MODEL),
        "w_gate_x": nrm((N_ODD, N_EXPERTS, D_MODEL, D_FF_EXPERT), D_MODEL),
        "w_up_x": nrm((N_ODD, N_EXPERTS, D_MODEL, D_FF_EXPERT), D_MODEL),
        "w_down_x": nrm((N_ODD, N_EXPERTS, D_FF_EXPERT, D_MODEL), D_FF_EXPERT),
        "norm_final": gain((D_MODEL,)),
    }


def reference(x, norm_mix_e, w_in_e, sgu_norm, w_spatial, b_spatial, w_pool, pool_scale,
              w_out_e, norm_ffn_e, w_gate_d, w_up_d, w_down_d,
              norm_mix_o, w_pw1, b_pw1, w_dw, b_dw, ln_g, ln_b, w_pw2, b_pw2,
              norm_ffn_o, w_router, w_gate_x, w_up_x, w_down_x, norm_final):
    h = x
    for layer in range(DEPTH):
        i = layer // 2
        if layer % 2 == 0:
            hn = rmsnorm(h, norm_mix_e[i])
            proj = hn @ w_in_e[i]
            uv = jax.nn.gelu(proj[..., :2 * A_WIDTH])
            u, v = uv[..., :A_WIDTH], uv[..., A_WIDTH:]
            z = proj[..., 2 * A_WIDTH:]
            a_out = chunked_sgu(u, v, sgu_norm[i], w_spatial[i], b_spatial[i])
            b_out = pool_mixer(z, w_pool[i], pool_scale[i])
            h = h + jnp.concatenate([a_out, b_out], axis=-1) @ w_out_e[i]
            h = h + swiglu(rmsnorm(h, norm_ffn_e[i]), w_gate_d[i], w_up_d[i], w_down_d[i])
        else:
            hn = rmsnorm(h, norm_mix_o[i])
            h = h + conformer_conv(hn, w_pw1[i], b_pw1[i], w_dw[i], b_dw[i],
                                   ln_g[i], ln_b[i], w_pw2[i], b_pw2[i])
            h = h + moe_swiglu(rmsnorm(h, norm_ffn_o[i]), w_router[i],
                               w_gate_x[i], w_up_x[i], w_down_x[i])
    return rmsnorm(h, norm_final)
```

```cpp
#include <hip/hip_runtime.h>
#include <cstdio>
#include <cstdint>
#include <cmath>
#ifndef MK_PER_PHASE
#define MK_PER_PHASE 0
#endif
namespace pg8 {
#define PG8_LAS __attribute__((address_space(3)))
typedef unsigned short bf16_t;
typedef short bf16x8 __attribute__((ext_vector_type(8)));
typedef float f32x4 __attribute__((ext_vector_type(4)));
typedef unsigned u32x4 __attribute__((ext_vector_type(4)));
constexpr int BM = 256, BK = 64, HALF = 128, HTB = HALF * BK * 2  , STAGE_BYTES = 8 * HTB, NXCD = 8, WGM = 8;

__host__ __device__ __forceinline__ int lds_byte(int r, int c) { const int st = (r >> 4) * 2 + (c >> 5), rr = r & 15, cc = c & 31, ob = rr * 64 + cc * 2; return st * 1024 + (ob ^ (((ob >> 9) & 1) << 5)); }
__host__ __device__ __forceinline__ void stage_rc(int b, int& R, int& C) { const int st = b / 1024, sb = b % 1024, swz = sb ^ (((sb >> 9) & 1) << 5); R = (st >> 1) * 16 + swz / 64; C = (st & 1) * 32 + (swz % 64) / 2; }
__host__ __device__ __forceinline__ int perm32(int rho) { const int n = rho >> 4, i = rho & 15; return 8 * (i >> 2) + 4 * n + (i & 3); }

struct Unit { int pm, pn, pb; };
struct Gemm { const bf16_t* A; const bf16_t* Bt; int M, N, K; };

struct StaticOrder {
    int nM, nN, nwg, G, c;
    __host__ __device__ void init(int M, int N, int G_, int c_) { nM = M / BM; nN = N / BM; nwg = nM * nN; G = G_; c = c_; }
    __host__ __device__ bool next(int i, Unit& u) const {
        const long L = (long)i * G + c; if (L >= nwg) return false;
        int wgid = (int)L; { const int q = nwg / NXCD, r = nwg % NXCD, xcd = wgid % NXCD, off = wgid / NXCD; wgid = (xcd < r ? xcd * (q + 1) : r * (q + 1) + (xcd - r) * q) + off; }
        const int nig = WGM * nN, gid = wgid / nig, fm = gid * WGM, gsz = (nM - fm) < WGM ? (nM - fm) : WGM;
        u.pm = fm + ((wgid % nig) % gsz); u.pn = (wgid % nig) / gsz; u.pb = u.pn; return true;
    }
    __device__ __forceinline__ void a_ready(const Unit&) const {}
    __device__ __forceinline__ void done(const Unit&) const {}
};


struct GroupedOrder {
    int nM, nN, nwg, G, c; int ts[9];
    __device__ __forceinline__ bool next(int i, Unit& u) const {
        const long L = (long)i * G + c; if (L >= nwg) return false;
        int wgid = (int)L; { const int q = nwg / NXCD, r = nwg % NXCD, xcd = wgid % NXCD, off = wgid / NXCD; wgid = (xcd < r ? xcd * (q + 1) : r * (q + 1) + (xcd - r) * q) + off; }
        const int nig = WGM * nN, gid = wgid / nig, fm = gid * WGM, gsz = (nM - fm) < WGM ? (nM - fm) : WGM;
        u.pm = fm + ((wgid % nig) % gsz); u.pn = (wgid % nig) / gsz;
        int e = 0;
#pragma unroll
        for (int j = 1; j < 8; ++j) e += (u.pm >= ts[j]) ? 1 : 0;
        u.pb = e * nN + u.pn; return true;
    }
    __device__ __forceinline__ void a_ready(const Unit&) const {}
    __device__ __forceinline__ void done(const Unit&) const {}
};

__device__ __forceinline__ unsigned cvt_pk_bf16(float lo, float hi) { unsigned r; asm volatile("v_cvt_pk_bf16_f32 %0, %1, %2" : "=v"(r) : "v"(lo), "v"(hi)); return r; }
__device__ __forceinline__ float fast_sigmoid(float x) { return __builtin_amdgcn_rcpf(1.0f + __builtin_amdgcn_exp2f(x * -1.4426950408889634f)); }
__device__ __forceinline__ float gelu_tanh(float x) {
    const float t = x * (1.0f + 0.044715f * x * x);
    return x * __builtin_amdgcn_rcpf(1.0f + __builtin_amdgcn_exp2f(t * -2.3022081986f));
}
__device__ __forceinline__ f32x4 gelu4(f32x4 v) { return (f32x4){gelu_tanh(v[0]), gelu_tanh(v[1]), gelu_tanh(v[2]), gelu_tanh(v[3])}; }

struct EpiGeluSplit {
    static constexpr bool PERM = true, AFTER_DRAIN = false;
    bf16_t* O; int ldc; int gelu_tiles;
    __device__ __forceinline__ void operator()(const f32x4 (&acc)[2][2][4][2], const Unit& u, int wr, int wc, int fr, int fq) const {
        const int row0 = u.pm * BM + wr * 64 + fr, col0 = u.pn * BM + wc * 32 + 8 * fq;
        const bool act = u.pn < gelu_tiles;
#pragma unroll
        for (int ai = 0; ai < 2; ++ai)
#pragma unroll
            for (int m = 0; m < 4; ++m) { bf16_t* rowp = O + (size_t)(row0 + ai * HALF + m * 16) * ldc + col0;
#pragma unroll
                for (int bj = 0; bj < 2; ++bj) { f32x4 v0 = acc[ai][bj][m][0], v1 = acc[ai][bj][m][1];
                    if (act) { v0 = gelu4(v0); v1 = gelu4(v1); }
                    u32x4 w; w.x = cvt_pk_bf16(v0[0], v0[1]); w.y = cvt_pk_bf16(v0[2], v0[3]); w.z = cvt_pk_bf16(v1[0], v1[1]); w.w = cvt_pk_bf16(v1[2], v1[3]);
                    *(u32x4*)(rowp + bj * HALF) = w; } }
    }
};
struct EpiRes {
    static constexpr bool PERM = false, AFTER_DRAIN = false;
    const float* base; float* out; int ldc; const float* bias;
    __device__ __forceinline__ void operator()(const f32x4 (&acc)[2][2][4][2], const Unit& u, int wr, int wc, int fr, int fq) const {
        const int row0 = u.pm * BM + wr * 64 + fr, col0 = u.pn * BM + wc * 32 + 4 * fq;
        f32x4 bv[2][2];
#pragma unroll
        for (int bj = 0; bj < 2; ++bj)
#pragma unroll
            for (int n = 0; n < 2; ++n) bv[bj][n] = bias ? *(const f32x4*)(bias + col0 + bj * HALF + n * 16) : (f32x4){0.f, 0.f, 0.f, 0.f};
#pragma unroll
        for (int ai = 0; ai < 2; ++ai)
#pragma unroll
            for (int m = 0; m < 4; ++m) { const size_t off = (size_t)(row0 + ai * HALF + m * 16) * ldc + col0;
#pragma unroll
                for (int bj = 0; bj < 2; ++bj)
#pragma unroll
                    for (int n = 0; n < 2; ++n) { const f32x4 bs = *(const f32x4*)(base + off + bj * HALF + n * 16);
                        *(f32x4*)(out + off + bj * HALF + n * 16) = bs + acc[ai][bj][m][n] + bv[bj][n]; } }
    }
};
template <int MODE> struct EpiGlu {
    static constexpr bool PERM = true, AFTER_DRAIN = false;
    bf16_t* O; int ldo; const float* bias0; const float* bias1;
    __device__ __forceinline__ void operator()(const f32x4 (&acc)[2][2][4][2], const Unit& u, int wr, int wc, int fr, int fq) const {
        const int row0 = u.pm * BM + wr * 64 + fr, ocol = u.pn * HALF + wc * 32 + 8 * fq;
        f32x4 b0[2], b1[2];
#pragma unroll
        for (int n = 0; n < 2; ++n) { b0[n] = (MODE == 1) ? *(const f32x4*)(bias0 + ocol + 4 * n) : (f32x4){0.f, 0.f, 0.f, 0.f}; b1[n] = (MODE == 1) ? *(const f32x4*)(bias1 + ocol + 4 * n) : (f32x4){0.f, 0.f, 0.f, 0.f}; }
#pragma unroll
        for (int ai = 0; ai < 2; ++ai)
#pragma unroll
            for (int m = 0; m < 4; ++m) { bf16_t* rowp = O + (size_t)(row0 + ai * HALF + m * 16) * ldo + ocol;
                f32x4 r[2];
#pragma unroll
                for (int n = 0; n < 2; ++n) { const f32x4 a = acc[ai][0][m][n] + b0[n], b = acc[ai][1][m][n] + b1[n];
#pragma unroll
                    for (int i = 0; i < 4; ++i) r[n][i] = (MODE == 0) ? (a[i] * fast_sigmoid(a[i]) * b[i]) : (a[i] * fast_sigmoid(b[i])); }
                u32x4 w; w.x = cvt_pk_bf16(r[0][0], r[0][1]); w.y = cvt_pk_bf16(r[0][2], r[0][3]); w.z = cvt_pk_bf16(r[1][0], r[1][1]); w.w = cvt_pk_bf16(r[1][2], r[1][3]);
                *(u32x4*)rowp = w; }
    }
};
struct EpiScale {
    static constexpr bool PERM = true, AFTER_DRAIN = false;
    bf16_t* O; int ldc; const float* rowscale;
    __device__ __forceinline__ void operator()(const f32x4 (&acc)[2][2][4][2], const Unit& u, int wr, int wc, int fr, int fq) const {
        const int row0 = u.pm * BM + wr * 64 + fr, col0 = u.pn * BM + wc * 32 + 8 * fq;
#pragma unroll
        for (int ai = 0; ai < 2; ++ai)
#pragma unroll
            for (int m = 0; m < 4; ++m) { const int row = row0 + ai * HALF + m * 16; const float s = rowscale[row]; bf16_t* rowp = O + (size_t)row * ldc + col0;
#pragma unroll
                for (int bj = 0; bj < 2; ++bj) { const f32x4 v0 = acc[ai][bj][m][0] * s, v1 = acc[ai][bj][m][1] * s;
                    u32x4 w; w.x = cvt_pk_bf16(v0[0], v0[1]); w.y = cvt_pk_bf16(v0[2], v0[3]); w.z = cvt_pk_bf16(v1[0], v1[1]); w.w = cvt_pk_bf16(v1[2], v1[3]);
                    *(u32x4*)(rowp + bj * HALF) = w; } }
    }
};

template <class Epi, class Sched, bool ALIGN_EPI = false, bool SP2 = false>
__device__ __forceinline__ void gemm_phase(PG8_LAS unsigned char* lds, const Gemm g, const Sched& S, const Epi& E) {
    int tid_l = threadIdx.x; asm volatile("" : "+v"(tid_l));
    const int tid = tid_l, wid = __builtin_amdgcn_readfirstlane(tid >> 6), lane = tid & 63, wr = wid >> 2, wc = wid & 3, fr = lane & 15, fq = lane >> 4;
    const int K = g.K, nt = K / BK;
    unsigned voffA[2], voffB[2];
#pragma unroll
    for (int i = 0; i < 2; ++i) { int R, C; stage_rc(tid * 16 + i * 8192, R, C); const int Rb = Epi::PERM ? ((R & ~31) + perm32(R & 31)) : R;
        voffA[i] = (unsigned)(R * K + C) * 2u; voffB[i] = (unsigned)(Rb * K + C) * 2u; }
    const size_t kstep = (size_t)(BK * 2);
    const size_t hstep = (size_t)HALF * K * 2;
    const size_t tstep = 2 * hstep;
    const unsigned ldsw = (unsigned)wid * 1024u;
    const int aoff = lds_byte(wr * 64 + fr, fq * 8), boff = lds_byte(wc * 32 + fr, fq * 8);
#define PG8_SA(b, h) (((b) * 2 + (h)) * HTB)
#define PG8_SB(b, h) ((4 + (b) * 2 + (h)) * HTB)
#define PG8_STAGE(bufoff, gbase, voff) do { _Pragma("unroll") for (int _i = 0; _i < 2; ++_i) \
        __builtin_amdgcn_global_load_lds((const unsigned*)((const char*)(gbase) + (voff)[_i]), (PG8_LAS unsigned*)(lds + (bufoff) + ldsw + _i * 8192), 16, 0, 0); } while (0)
#define PG8_LDA(dst, b, h) do { _Pragma("unroll") for (int m = 0; m < 4; ++m) _Pragma("unroll") for (int k = 0; k < 2; ++k) dst[m][k] = *(const PG8_LAS bf16x8*)(lds + PG8_SA(b, h) + aoff + m * 2048 + k * 1024); } while (0)
#define PG8_LDB(dst, b, h) do { _Pragma("unroll") for (int n = 0; n < 2; ++n) _Pragma("unroll") for (int k = 0; k < 2; ++k) dst[n][k] = *(const PG8_LAS bf16x8*)(lds + PG8_SB(b, h) + boff + n * 2048 + k * 1024); } while (0)
#define PG8_MMA(ai, bj, At, Bt) do { __builtin_amdgcn_s_setprio(1); _Pragma("unroll") for (int m = 0; m < 4; ++m) _Pragma("unroll") for (int n = 0; n < 2; ++n) _Pragma("unroll") for (int k = 0; k < 2; ++k) \
        acc[ai][bj][m][n] = __builtin_amdgcn_mfma_f32_16x16x32_bf16(Bt[n][k], At[m][k], acc[ai][bj][m][n], 0, 0, 0); __builtin_amdgcn_s_setprio(0); } while (0)
#define PG8_WAIT_V(n) asm volatile("s_waitcnt vmcnt(" #n ")" ::: "memory")
#define PG8_WAIT_L(n) asm volatile("s_waitcnt lgkmcnt(" #n ")" ::: "memory")
#define PG8_BAR __builtin_amdgcn_s_barrier()
#define PG8_SCHED __builtin_amdgcn_sched_barrier(0)
    Unit cur, nxt; int ui = 0;
    if (!S.next(0, cur)) return;
    f32x4 acc[2][2][4][2];
#pragma unroll
    for (int a = 0; a < 2; ++a)
#pragma unroll
        for (int b = 0; b < 2; ++b)
#pragma unroll
            for (int m = 0; m < 4; ++m)
#pragma unroll
                for (int n = 0; n < 2; ++n) acc[a][b][m][n] = (f32x4){0.f, 0.f, 0.f, 0.f};
    bf16x8 At[4][2], B0[2][2], B1[2][2];
    const char* cA = (const char*)g.A + (size_t)cur.pm * tstep; const char* cB = (const char*)g.Bt + (size_t)cur.pb * tstep;
    S.a_ready(cur);
    if constexpr (SP2) {
        PG8_STAGE(PG8_SB(0, 0), cB, voffB); PG8_STAGE(PG8_SB(0, 1), cB + hstep, voffB); PG8_STAGE(PG8_SA(0, 0), cA, voffA); PG8_STAGE(PG8_SA(0, 1), cA + hstep, voffA);
        if (wr == 1) PG8_BAR;
        PG8_WAIT_V(2); PG8_BAR;
        PG8_STAGE(PG8_SB(1, 0), cB + kstep, voffB); PG8_STAGE(PG8_SA(1, 0), cA + kstep, voffA); PG8_STAGE(PG8_SB(1, 1), cB + hstep + kstep, voffB);
        PG8_WAIT_V(6); PG8_BAR;
    } else {
        PG8_STAGE(PG8_SB(0, 0), cB, voffB); PG8_STAGE(PG8_SA(0, 0), cA, voffA); PG8_STAGE(PG8_SB(0, 1), cB + hstep, voffB); PG8_STAGE(PG8_SA(0, 1), cA + hstep, voffA);
        if (wr == 1) PG8_BAR;
        PG8_WAIT_V(4); PG8_BAR;
        PG8_STAGE(PG8_SB(1, 0), cB + kstep, voffB); PG8_STAGE(PG8_SA(1, 0), cA + kstep, voffA); PG8_STAGE(PG8_SB(1, 1), cB + hstep + kstep, voffB);
        PG8_WAIT_V(6); PG8_BAR;
    }
    for (;;) {
        const bool has_next = S.next(ui + 1, nxt);
        const char* nA = has_next ? (const char*)g.A + (size_t)nxt.pm * tstep : cA; const char* nB = has_next ? (const char*)g.Bt + (size_t)nxt.pb * tstep : cB;
        for (int t = 0; t < nt; t += 2) {
            const bool last = (t == nt - 2);
            const char* a1 = cA + (size_t)(t + 1) * kstep;
            const char* a2 = last ? nA : cA + (size_t)(t + 2) * kstep; const char* b2 = last ? nB : cB + (size_t)(t + 2) * kstep;
            const char* a3 = a2 + kstep; const char* b3 = b2 + kstep;
            if (last && has_next) S.a_ready(nxt);
            if constexpr (SP2) {
            PG8_LDB(B0, 0, 0); PG8_LDB(B1, 0, 1); PG8_SCHED; PG8_LDA(At, 0, 0); PG8_STAGE(PG8_SA(1, 1), a1 + hstep, voffA);
            PG8_WAIT_V(8); PG8_WAIT_L(0); PG8_BAR; PG8_MMA(0, 0, At, B0); PG8_MMA(0, 1, At, B1); PG8_BAR; PG8_SCHED;
            PG8_LDA(At, 0, 1); PG8_STAGE(PG8_SB(0, 0), b2, voffB); PG8_STAGE(PG8_SB(0, 1), b2 + hstep, voffB); PG8_STAGE(PG8_SA(0, 0), a2, voffA);
            PG8_WAIT_V(8); PG8_WAIT_L(0); PG8_BAR; PG8_MMA(1, 0, At, B0); PG8_MMA(1, 1, At, B1); PG8_BAR; PG8_SCHED;
            PG8_LDB(B0, 1, 0); PG8_LDB(B1, 1, 1); PG8_SCHED; PG8_LDA(At, 1, 0); PG8_STAGE(PG8_SA(0, 1), a2 + hstep, voffA);
            PG8_WAIT_V(8); PG8_WAIT_L(0); PG8_BAR; PG8_MMA(0, 0, At, B0); PG8_MMA(0, 1, At, B1); PG8_BAR; PG8_SCHED;
            PG8_LDA(At, 1, 1); PG8_STAGE(PG8_SB(1, 0), b3, voffB); PG8_STAGE(PG8_SB(1, 1), b3 + hstep, voffB); PG8_STAGE(PG8_SA(1, 0), a3, voffA);
            PG8_WAIT_V(8); PG8_WAIT_L(0); PG8_BAR; PG8_MMA(1, 0, At, B0); PG8_MMA(1, 1, At, B1); PG8_BAR; PG8_SCHED;
            } else {
            PG8_LDB(B0, 0, 0); PG8_SCHED; PG8_LDA(At, 0, 0); PG8_STAGE(PG8_SA(1, 1), a1 + hstep, voffA);
            PG8_WAIT_L(8); PG8_BAR; PG8_WAIT_L(0); PG8_MMA(0, 0, At, B0); PG8_BAR; PG8_SCHED;
            PG8_LDB(B1, 0, 1); PG8_STAGE(PG8_SB(0, 0), b2, voffB);
            PG8_BAR; PG8_WAIT_L(0); PG8_MMA(0, 1, At, B1); PG8_BAR;
            PG8_LDA(At, 0, 1); PG8_STAGE(PG8_SA(0, 0), a2, voffA);
            PG8_BAR; PG8_WAIT_L(0); PG8_MMA(1, 0, At, B0); PG8_BAR; PG8_SCHED;
            PG8_STAGE(PG8_SB(0, 1), b2 + hstep, voffB);
            PG8_WAIT_V(6); PG8_BAR; PG8_MMA(1, 1, At, B1); PG8_BAR;
            PG8_LDB(B0, 1, 0); PG8_SCHED; PG8_LDA(At, 1, 0); PG8_STAGE(PG8_SA(0, 1), a2 + hstep, voffA);
            PG8_WAIT_L(8); PG8_BAR; PG8_WAIT_L(0); PG8_MMA(0, 0, At, B0); PG8_BAR; PG8_SCHED;
            PG8_LDB(B1, 1, 1); PG8_STAGE(PG8_SB(1, 0), b3, voffB);
            PG8_BAR; PG8_WAIT_L(0); PG8_MMA(0, 1, At, B1); PG8_BAR;
            PG8_LDA(At, 1, 1); PG8_STAGE(PG8_SA(1, 0), a3, voffA);
            PG8_BAR; PG8_WAIT_L(0); PG8_MMA(1, 0, At, B0); PG8_BAR; PG8_SCHED;
            PG8_STAGE(PG8_SB(1, 1), b3 + hstep, voffB);
            PG8_WAIT_V(6); PG8_BAR; PG8_MMA(1, 1, At, B1); PG8_BAR;
            }
        }
        if constexpr (ALIGN_EPI) { if (wr == 0) PG8_BAR; }
        if constexpr (!Epi::AFTER_DRAIN) { E(acc, cur, wr, wc, fr, fq); S.done(cur); }
        if (!has_next) break;
#pragma unroll
        for (int a = 0; a < 2; ++a)
#pragma unroll
            for (int b = 0; b < 2; ++b)
#pragma unroll
                for (int m = 0; m < 4; ++m)
#pragma unroll
                    for (int n = 0; n < 2; ++n) acc[a][b][m][n] = (f32x4){0.f, 0.f, 0.f, 0.f};
        cur = nxt; cA = nA; cB = nB; ++ui;
        if constexpr (ALIGN_EPI) { if (wr == 1) PG8_BAR; }
    }
    PG8_WAIT_V(0);
    if constexpr (!ALIGN_EPI) { if (wr == 0) PG8_BAR; }
    PG8_BAR;
    if constexpr (Epi::AFTER_DRAIN) { E.fused(acc, cur, wr, wc, fr, fq, lds, wid, lane); S.done(cur); }
#undef PG8_SA
#undef PG8_SB
#undef PG8_STAGE
#undef PG8_LDA
#undef PG8_LDB
#undef PG8_MMA
#undef PG8_WAIT_V
#undef PG8_WAIT_L
#undef PG8_BAR
#undef PG8_SCHED
}
}

constexpr int NWAVES = 8;
#ifndef MK_PER_PHASE
#define MK_PER_PHASE 0
#endif

constexpr int BATCH = 4, SEQ = 4096, D = 1024, M = BATCH * SEQ;
constexpr int INE = 1536, AW = 512, NHEAD = 8, HD = 64, CHUNK = 128, BW = 512, NGRP = 4, GD = 128;
constexpr int FFD = 2816, NEXP = 8, FFX = 3584, CONVK = 31;
constexpr float EPS = 1e-6f;
constexpr int MSLOT = 2 * M + NEXP * 256;
constexpr int NPH = 31;

constexpr size_t MiB = 1u << 20;
constexpr size_t WS_CTL = 0, CTL_ZERO_BYTES = 1 * MiB;
constexpr size_t WS_WE = 1 * MiB, WE_STRIDE = 23 * MiB;
constexpr size_t WE_IN = 0, WE_OUT = 3 * MiB, WE_GU = 5 * MiB, WE_DN = 16 * MiB, WE_SP = 21 * MiB + 512 * 1024, WE_PL = 21 * MiB + 768 * 1024;
constexpr size_t WS_WO = 47 * MiB, WO_STRIDE = 174 * MiB;
constexpr size_t WO_PW1 = 0, WO_PW2 = 4 * MiB, WO_GUX = 6 * MiB, WO_DNX = 118 * MiB;
constexpr size_t WS_H = 395 * MiB;
constexpr size_t WS_HN = 459 * MiB;
constexpr size_t WS_R = 491 * MiB;
constexpr size_t WS_PROJ = WS_R, WS_MIX = WS_R + 48 * MiB, WS_ACT = WS_R + 80 * MiB;
constexpr size_t WS_GLU = WS_R, WS_CV = WS_R + 32 * MiB;
constexpr size_t WS_HP = WS_R, WS_ACTX = WS_R + 68 * MiB, WS_Y = WS_R + 306 * MiB;
constexpr size_t WS_TOKINFO = 865 * MiB, WS_TOKSLOT = WS_TOKINFO + 256 * 1024, WS_SLOTGATE = WS_TOKSLOT + 128 * 1024, WS_END = 866 * MiB;
static_assert(WS_WE + 2 * WE_STRIDE <= WS_WO && WS_WO + 2 * WO_STRIDE <= WS_H && WS_H + (size_t)M * D * 4 <= WS_HN && WS_HN + (size_t)M * D * 2 <= WS_R, "ws map");
static_assert(WS_ACT + (size_t)M * FFD * 2 <= WS_TOKINFO && WS_ACTX + (size_t)MSLOT * FFX * 2 <= WS_Y && WS_Y + (size_t)MSLOT * D * 2 <= WS_TOKINFO && (size_t)MSLOT * D * 2 <= 68 * MiB, "ws map 2");
static_assert(WS_SLOTGATE + (size_t)MSLOT * 4 <= WS_END && WS_END <= 896 * MiB, "ws map 3");
constexpr int CW_TMO = 0, CW_CODE = 1;
constexpr int CW_BAR = 4096;
constexpr int CW_MOE = 8192;

constexpr int RING_OFF = 0, RING_BYTES = 141312;
constexpr int LDSCTL_OFF = RING_BYTES, MISC_OFF = LDSCTL_OFF + 320;
constexpr int LDS_BYTES = 147456;
static_assert(MISC_OFF + 128 <= LDS_BYTES, "LDS map");

#define GAS __attribute__((address_space(1)))
#define LAS __attribute__((address_space(3)))
typedef unsigned short bf16;
typedef unsigned v4u __attribute__((ext_vector_type(4)));
typedef float f32x4 __attribute__((ext_vector_type(4)));
typedef short bf16x8 __attribute__((ext_vector_type(8)));
typedef GAS unsigned gu32;
typedef GAS unsigned long long gu64;
#define RLX_AGENT __ATOMIC_RELAXED, __HIP_MEMORY_SCOPE_AGENT
#define LDS_WAIT() asm volatile("s_waitcnt lgkmcnt(0)" ::: "memory")
#define VM_WAIT() asm volatile("s_waitcnt vmcnt(0)" ::: "memory")
__device__ __forceinline__ unsigned long long rt() { return __builtin_amdgcn_s_memrealtime(); }
__device__ __forceinline__ unsigned f2bf(float f) { unsigned u = __builtin_bit_cast(unsigned, f); return (u + 0x7fffu + ((u >> 16) & 1u)) >> 16; }
__device__ __forceinline__ unsigned pk2(float lo, float hi) { return f2bf(lo) | (f2bf(hi) << 16); }

#define XB_TMO      128
#define XB_XCNT(j)  (256  + 64 * (j))
#define XB_XSUB(j)  (1280 + 64 * (j))
#define XB_XGEN(j)  (2304 + 64 * (j))
#define XB_TOP      3328
#define XB_TOPGEN   3392
#define XCD_BAR_WORDS 3456
#define XB_SPIN_CAP (1u << 18)

__device__ __forceinline__ unsigned xb_ld(unsigned* p)              { return __hip_atomic_load(p, __ATOMIC_RELAXED, __HIP_MEMORY_SCOPE_AGENT); }
__device__ __forceinline__ unsigned xb_add(unsigned* p, unsigned v) { return __hip_atomic_fetch_add(p, v, __ATOMIC_RELAXED, __HIP_MEMORY_SCOPE_AGENT); }
__device__ __forceinline__ unsigned xb_xcc_id() { return (unsigned)__builtin_amdgcn_s_getreg((3 << 11) | 20) & 0xFu; }
#define XB_SPIN(cond, bar) do { unsigned _sp = 0; while (cond) { __builtin_amdgcn_s_sleep(1); \
    if ((++_sp & 255u) == 0u) { if (xb_ld(&(bar)[XB_TMO])) break; if (_sp > XB_SPIN_CAP) { atomicAdd(&(bar)[XB_TMO], 1u); break; } } } } while (0)

struct XcdBarrier {
    unsigned* bar; unsigned x;
    volatile LAS unsigned* st;
};

__device__ __forceinline__ XcdBarrier xcd_barrier_post(unsigned* bar, volatile LAS unsigned* st) {
    XcdBarrier b; b.bar = bar; b.x = xb_xcc_id(); b.st = st;
    if (threadIdx.x == 0) (void)xb_add(&bar[XB_XCNT(b.x)], 1u);
    return b;
}
__device__ __forceinline__ void xcd_barrier_complete(unsigned* bar, unsigned x, unsigned& nloc, unsigned& nx) {
    const unsigned G = gridDim.x * gridDim.y * gridDim.z;
    unsigned sum, cnt, mine, sp = 0u;
    for (;;) {
        sum = 0u; cnt = 0u; mine = 0u;
#pragma unroll 1
        for (unsigned j = 0; j < 16; ++j) { const unsigned c = xb_ld(&bar[XB_XCNT(j)]); sum += c; cnt += (c > 0u) ? 1u : 0u; mine = (j == x) ? c : mine; }
        if (sum == G) break;
        __builtin_amdgcn_s_sleep(1);
        if ((++sp & 255u) == 0u) { if (xb_ld(&bar[XB_TMO])) break; if (sp > XB_SPIN_CAP) { atomicAdd(&bar[XB_TMO], 1u); break; } }
    }
    nloc = mine > 0u ? mine : 1u; nx = cnt > 0u ? cnt : 1u;
}

__device__ __forceinline__ void xcd_barrier(const XcdBarrier& b) {
    asm volatile("s_waitcnt vmcnt(0)" ::: "memory");
    __syncthreads();
    if (threadIdx.x == 0) {
        unsigned* bar = b.bar;
        __builtin_amdgcn_s_waitcnt(0);
        unsigned nloc = b.st[0], nx = b.st[1];
        if (nloc == 0u) { xcd_barrier_complete(bar, b.x, nloc, nx); b.st[0] = nloc; b.st[1] = nx; }
        const unsigned old = xb_add(&bar[XB_XSUB(b.x)], 1u);
        const unsigned gen = old / nloc;
        if (old + 1u == (gen + 1u) * nloc) {
            __builtin_amdgcn_fence(__ATOMIC_RELEASE, "agent");
            asm volatile("s_waitcnt vmcnt(0)" ::: "memory");
            const unsigned og = xb_add(&bar[XB_TOP], 1u);
            const unsigned tg = og / nx;
            if (og + 1u == (tg + 1u) * nx) xb_add(&bar[XB_TOPGEN], 1u);
            else XB_SPIN(xb_ld(&bar[XB_TOPGEN]) == tg, bar);
            __builtin_amdgcn_fence(__ATOMIC_ACQUIRE, "agent");
            xb_add(&bar[XB_XGEN(b.x)], 1u);
            asm volatile("s_waitcnt vmcnt(0)" ::: "memory");
        } else {
            XB_SPIN(xb_ld(&bar[XB_XGEN(b.x)]) == gen, bar);
            __builtin_amdgcn_fence(__ATOMIC_ACQUIRE, "agent");
            asm volatile("s_waitcnt vmcnt(0)" ::: "memory");
        }
    }
    __syncthreads();
}

typedef float f32x2 __attribute__((ext_vector_type(2)));
typedef unsigned u32x2 __attribute__((ext_vector_type(2)));
typedef int i32x4 __attribute__((ext_vector_type(4)));
typedef int i32x2 __attribute__((ext_vector_type(2)));
struct Frame {
    LAS unsigned char* lds;
    volatile LAS unsigned* MISC;
    gu32* ctl;
    int tid, lane, wave;
    int vcu, G;
    const float* const* in;
    unsigned char* ws; float* out;
};
__device__ __forceinline__ float bf_lo(unsigned u) { return __uint_as_float(u << 16); }
__device__ __forceinline__ float bf_hi(unsigned u) { return __uint_as_float(u & 0xffff0000u); }
__device__ __forceinline__ unsigned pkbf(float lo, float hi) { return pg8::cvt_pk_bf16(lo, hi); }
__device__ __forceinline__ float wave_sum(float v) {
#pragma unroll
    for (int o = 1; o < 64; o <<= 1) v += __shfl_xor(v, o);
    return v;
}
__device__ __forceinline__ float dot4(f32x4 a, f32x4 b) { return (a.x * b.x + a.y * b.y) + (a.z * b.z + a.w * b.w); }
__device__ __forceinline__ float silu_f(float x) { return x * pg8::fast_sigmoid(x); }

__device__ __forceinline__ void tr_item(const float* W, int ldn, bf16* dst, int ldk, LAS float* scr, int lane) {
#pragma unroll 16
    for (int i = 0; i < 64; ++i) scr[i * 65 + lane] = W[(size_t)i * ldn + lane];
    LDS_WAIT(); asm volatile("" ::: "memory");
    const int c = lane & 7;
#pragma unroll
    for (int j = 0; j < 8; ++j) { const int n = (lane >> 3) + 8 * j; const LAS float* s = scr + (8 * c) * 65 + n;
        v4u o; o.x = pkbf(s[0 * 65], s[1 * 65]); o.y = pkbf(s[2 * 65], s[3 * 65]); o.z = pkbf(s[4 * 65], s[5 * 65]); o.w = pkbf(s[6 * 65], s[7 * 65]);
        *(GAS v4u*)(dst + (size_t)n * ldk + 8 * c) = o; }
    LDS_WAIT(); asm volatile("" ::: "memory");
}
__device__ __forceinline__ void tr_plain(const float* W, int K, int N, bf16* dst, int r, LAS float* scr, int lane) {
    const int nb = N / 64, kb = r / nb, nn = r % nb;
    tr_item(W + (size_t)(kb * 64) * N + nn * 64, N, dst + (size_t)(nn * 64) * K + kb * 64, K, scr, lane);
}
__device__ __forceinline__ void tr_pair(const float* W, int K, int N, bf16* dst, int half, int r, LAS float* scr, int lane) {
    const int nb = N / 64, kb = r / nb, nn = r % nb, n0 = nn * 64;
    const int drow = (n0 >> 7) * 256 + half * 128 + (n0 & 127);
    tr_item(W + (size_t)(kb * 64) * N + n0, N, dst + (size_t)drow * K + kb * 64, K, scr, lane);
}
__device__ __forceinline__ void p0_prologue(Frame& F, const float* const* kargs) {
#define in(k) ({ const float* const* p_ = kargs; asm volatile("" : "+s"(p_)); p_[k]; })
    int tid_l = F.tid; asm volatile("" : "+v"(tid_l)); const int tid = tid_l, lane = tid & 63, wave = __builtin_amdgcn_readfirstlane(tid >> 6); (void)tid; (void)lane; (void)wave;
    LAS float* scr = (LAS float*)(F.lds + RING_OFF + wave * 16640);
    const int gw = F.vcu * NWAVES + wave, NGW = F.G * NWAVES;
    constexpr int I_IN = 16 * 24, I_OUT = 16 * 16, I_GD = 16 * 44, I_DN = 44 * 16, I_PW1 = 16 * 16  , I_PW2 = 16 * 16, I_GX = 16 * 56  , I_DX = 56 * 16  , I_PL = 4  ;
    constexpr int NIT = I_IN + I_OUT + 2 * I_GD + I_DN + 2 * I_PW1 + I_PW2 + NEXP * (2 * I_GX + I_DX) + NGRP * I_PL;
    for (int li = 0; li < 2; ++li) {
        unsigned char* we = F.ws + WS_WE + (size_t)li * WE_STRIDE; unsigned char* wo = F.ws + WS_WO + (size_t)li * WO_STRIDE;
        for (int it = gw; it < NIT; it += NGW) {
            int r = it;
            if (r < NEXP * I_GX) { const int e = r / I_GX; tr_pair(in(24) + ((size_t)li * NEXP + e) * D * FFX, D, FFX, (bf16*)(wo + WO_GUX) + (size_t)e * 2 * FFX * D, 0, r % I_GX, scr, lane); continue; } r -= NEXP * I_GX;
            if (r < NEXP * I_GX) { const int e = r / I_GX; tr_pair(in(25) + ((size_t)li * NEXP + e) * D * FFX, D, FFX, (bf16*)(wo + WO_GUX) + (size_t)e * 2 * FFX * D, 1, r % I_GX, scr, lane); continue; } r -= NEXP * I_GX;
            if (r < NEXP * I_DX) { const int e = r / I_DX; tr_plain(in(26) + ((size_t)li * NEXP + e) * FFX * D, FFX, D, (bf16*)(wo + WO_DNX) + (size_t)e * D * FFX, r % I_DX, scr, lane); continue; } r -= NEXP * I_DX;
            if (r < I_IN) { tr_plain(in(2) + (size_t)li * D * INE, D, INE, (bf16*)(we + WE_IN), r, scr, lane); continue; } r -= I_IN;
            if (r < I_OUT) { tr_plain(in(8) + (size_t)li * D * D, D, D, (bf16*)(we + WE_OUT), r, scr, lane); continue; } r -= I_OUT;
            if (r < I_GD) { tr_pair(in(10) + (size_t)li * D * FFD, D, FFD, (bf16*)(we + WE_GU), 0, r, scr, lane); continue; } r -= I_GD;
            if (r < I_GD) { tr_pair(in(11) + (size_t)li * D * FFD, D, FFD, (bf16*)(we + WE_GU), 1, r, scr, lane); continue; } r -= I_GD;
            if (r < I_DN) { tr_plain(in(12) + (size_t)li * FFD * D, FFD, D, (bf16*)(we + WE_DN), r, scr, lane); continue; } r -= I_DN;
            if (r < 2 * I_PW1) { const int half = r / I_PW1, q = r % I_PW1, kb = q / 16, nn = q % 16, n0 = nn * 64;
                tr_item(in(14) + (size_t)li * D * 2 * D + (size_t)(kb * 64) * (2 * D) + half * D + n0, 2 * D, (bf16*)(wo + WO_PW1) + (size_t)((n0 >> 7) * 256 + half * 128 + (n0 & 127)) * D + kb * 64, D, scr, lane); continue; } r -= 2 * I_PW1;
            if (r < I_PW2) { tr_plain(in(20) + (size_t)li * D * D, D, D, (bf16*)(wo + WO_PW2), r, scr, lane); continue; } r -= I_PW2;
            { const int g = r / I_PL; tr_plain(in(6) + ((size_t)li * NGRP + g) * GD * GD, GD, GD, (bf16*)(we + WE_PL) + (size_t)g * GD * GD, r % I_PL, scr, lane); }
        }
        { const float* wsp = in(4) + (size_t)li * NHEAD * CHUNK * CHUNK; bf16* dsp = (bf16*)(we + WE_SP);
          for (int q = (F.vcu * NWAVES * 64 + tid); q < NHEAD * CHUNK * CHUNK / 4; q += F.G * NWAVES * 64) {
              const int e0 = q * 4, t = (e0 >> 7) & 127, s = e0 & 127; const f32x4 v = *(const f32x4*)(wsp + e0);
              u32x2 o; o.x = pkbf(s + 0 <= t ? v.x : 0.f, s + 1 <= t ? v.y : 0.f); o.y = pkbf(s + 2 <= t ? v.z : 0.f, s + 3 <= t ? v.w : 0.f);
              *(GAS u32x2*)(dsp + e0) = o; } }
    }
#undef in
}
__device__ __forceinline__ void rms_phase(Frame& F, const float* src, const float* gain, bf16* dst) {
    int tid_l = F.tid; asm volatile("" : "+v"(tid_l)); const int tid = tid_l, lane = tid & 63, wave = __builtin_amdgcn_readfirstlane(tid >> 6); (void)tid; (void)lane; (void)wave;
    const int gw = F.vcu * NWAVES + wave, NGW = F.G * NWAVES;
    f32x4 g[4];
#pragma unroll
    for (int j = 0; j < 4; ++j) g[j] = *(const f32x4*)(gain + 4 * lane + 256 * j);
    for (int m = gw; m < M; m += NGW) {
        const GAS f32x4* xr = (const GAS f32x4*)(src + (size_t)m * D) + lane;
        f32x4 v[4]; float s = 0.f;
#pragma unroll
        for (int j = 0; j < 4; ++j) { v[j] = xr[64 * j]; s += dot4(v[j], v[j]); }
        const float rstd = 1.0f / sqrtf(wave_sum(s) * (1.f / D) + EPS);
        GAS u32x2* o8 = (GAS u32x2*)(dst + (size_t)m * D) + lane;
#pragma unroll
        for (int j = 0; j < 4; ++j) { const f32x4 y = v[j] * rstd * g[j]; u32x2 w; w.x = pkbf(y.x, y.y); w.y = pkbf(y.z, y.w); o8[64 * j] = w; }
    }
}
constexpr int TSTR = 272;
__device__ __forceinline__ void mixer_phase(Frame& F, int li, const float* sgu_norm, const float* b_spatial, const float* pool_scale) {
    const bf16* proj = (const bf16*)(F.ws + WS_PROJ); bf16* mix = (bf16*)(F.ws + WS_MIX);
    const bf16* wsp = (const bf16*)(F.ws + WS_WE + (size_t)li * WE_STRIDE + WE_SP); const bf16* wpl = (const bf16*)(F.ws + WS_WE + (size_t)li * WE_STRIDE + WE_PL);
    int tid_l = F.tid; asm volatile("" : "+v"(tid_l)); const int tid = tid_l, lane = tid & 63, wave = __builtin_amdgcn_readfirstlane(tid >> 6); (void)tid; (void)lane; (void)wave;
    const int fr = lane & 15, fq = lane >> 4;
    LAS float* rs = (LAS float*)(F.lds + RING_OFF);
    LAS unsigned char* T = F.lds + RING_OFF + 512 + wave * (64 * TSTR);
    for (int u = F.vcu; u < 2 * (M / CHUNK); u += F.G) {
        const int chunk = u >> 1, part = u & 1, tok0 = chunk * CHUNK;
        if (part == 0) {
            const bf16* vbase = proj + (size_t)tok0 * INE + AW;
#pragma unroll 4
            for (int r = 0; r < 16; ++r) { const int row = wave * 16 + r; const v4u q = *(const GAS v4u*)(vbase + (size_t)row * INE + lane * 8);
                float s = 0.f;
#pragma unroll
                for (int k = 0; k < 4; ++k) { const float a = bf_lo(q[k]), b = bf_hi(q[k]); s += a * a + b * b; }
                s = wave_sum(s); if (lane == 0) rs[row] = 1.0f / sqrtf(s * (1.f / AW) + EPS); }
            __syncthreads();
            const int h = wave, rp = lane >> 3, cg = lane & 7;
            { const f32x4 ga = *(const f32x4*)(sgu_norm + li * AW + h * HD + cg * 8), gb = *(const f32x4*)(sgu_norm + li * AW + h * HD + cg * 8 + 4);
              const float gv[8] = {ga.x, ga.y, ga.z, ga.w, gb.x, gb.y, gb.z, gb.w};
#pragma unroll
              for (int st = 0; st < 8; ++st) { const int s = st * 16 + 2 * rp;
                  const v4u q0 = *(const GAS v4u*)(vbase + (size_t)s * INE + h * HD + cg * 8), q1 = *(const GAS v4u*)(vbase + (size_t)(s + 1) * INE + h * HD + cg * 8);
                  const float r0 = rs[s], r1 = rs[s + 1];
#pragma unroll
                  for (int k = 0; k < 4; ++k) {
                      *(LAS unsigned*)(T + (cg * 8 + 2 * k) * TSTR + s * 2) = pkbf(bf_lo(q0[k]) * r0 * gv[2 * k], bf_lo(q1[k]) * r1 * gv[2 * k]);
                      *(LAS unsigned*)(T + (cg * 8 + 2 * k + 1) * TSTR + s * 2) = pkbf(bf_hi(q0[k]) * r0 * gv[2 * k + 1], bf_hi(q1[k]) * r1 * gv[2 * k + 1]); } } }
            LDS_WAIT(); asm volatile("" ::: "memory");
            const bf16* Wh = wsp + (size_t)h * CHUNK * CHUNK; const float* bs = b_spatial + (li * NHEAD + h) * CHUNK;
#pragma unroll
            for (int ti = 0; ti < 8; ++ti) {
                constexpr int dummy = 0; (void)dummy;
                const int nks = ti / 2 + 1;
                bf16x8 bw[4];
#pragma unroll
                for (int ks = 0; ks < 4; ++ks) if (ks < nks) bw[ks] = *(const GAS bf16x8*)(Wh + (size_t)(16 * ti + fr) * CHUNK + 32 * ks + 8 * fq);
                const int t = 16 * ti + fr; const float bt = bs[t]; const size_t tok = (size_t)tok0 + t;
#pragma unroll
                for (int dj = 0; dj < 4; ++dj) {
                    f32x4 acc = (f32x4){0.f, 0.f, 0.f, 0.f};
#pragma unroll
                    for (int ks = 0; ks < 4; ++ks) if (ks < nks) { const bf16x8 a = *(const LAS bf16x8*)(T + (16 * dj + fr) * TSTR + (32 * ks + 8 * fq) * 2); acc = __builtin_amdgcn_mfma_f32_16x16x32_bf16(a, bw[ks], acc, 0, 0, 0); }
                    const int d = 16 * dj + 4 * fq;
                    const u32x2 uu = *(const GAS u32x2*)(proj + tok * INE + h * HD + d);
                    u32x2 o; o.x = pkbf(bf_lo(uu.x) * (acc[0] + bt), bf_hi(uu.x) * (acc[1] + bt)); o.y = pkbf(bf_lo(uu.y) * (acc[2] + bt), bf_hi(uu.y) * (acc[3] + bt));
                    *(GAS u32x2*)(mix + tok * D + h * HD + d) = o;
                }
            }
        } else {
            const int g = wave >> 1, rh = wave & 1, win = 2 << g;
            const int p0 = (tok0 & (SEQ - 1)) + 64 * rh;
            const size_t tokr = (size_t)tok0 + 64 * rh;
            const bf16* zb = proj + 2 * AW + g * GD + 2 * lane;
            float sx = 0.f, sy = 0.f;
#pragma unroll
            for (int j = 1; j <= 16; ++j) { const bool valid = (j <= win) && (p0 - j >= 0); const size_t row = valid ? tokr - j : tokr;
                const unsigned q = *(const GAS unsigned*)(zb + row * INE); sx += valid ? bf_lo(q) : 0.f; sy += valid ? bf_hi(q) : 0.f; }
#pragma unroll 8
            for (int i = 0; i < 64; ++i) { const bool valid = (p0 + i - win >= 0); const size_t rowo = valid ? tokr + i - win : tokr;
                const unsigned q = *(const GAS unsigned*)(zb + (tokr + i) * INE), qo = *(const GAS unsigned*)(zb + rowo * INE);
                const float zx = bf_lo(q), zy = bf_hi(q);
                sx += zx - (valid ? bf_lo(qo) : 0.f); sy += zy - (valid ? bf_hi(qo) : 0.f);
                const int cnt = (p0 + i + 1 < win) ? (p0 + i + 1) : win; const float inv = 1.0f / (float)cnt;
                *(LAS unsigned*)(T + i * TSTR + lane * 4) = pkbf(sx * inv - zx, sy * inv - zy); }
            LDS_WAIT(); asm volatile("" ::: "memory");
            const bf16* Wp = wpl + (size_t)g * GD * GD;
            bf16x8 bm[4][4];
#pragma unroll
            for (int ti = 0; ti < 4; ++ti)
#pragma unroll
                for (int ks = 0; ks < 4; ++ks) bm[ti][ks] = *(const LAS bf16x8*)(T + (16 * ti + fr) * TSTR + (32 * ks + 8 * fq) * 2);
#pragma unroll 2
            for (int dj = 0; dj < 8; ++dj) {
                bf16x8 aw[4];
#pragma unroll
                for (int ks = 0; ks < 4; ++ks) aw[ks] = *(const GAS bf16x8*)(Wp + (size_t)(16 * dj + fr) * GD + 32 * ks + 8 * fq);
                const f32x4 sc = *(const f32x4*)(pool_scale + li * BW + g * GD + 16 * dj + 4 * fq);
#pragma unroll
                for (int ti = 0; ti < 4; ++ti) {
                    f32x4 acc = (f32x4){0.f, 0.f, 0.f, 0.f};
#pragma unroll
                    for (int ks = 0; ks < 4; ++ks) acc = __builtin_amdgcn_mfma_f32_16x16x32_bf16(aw[ks], bm[ti][ks], acc, 0, 0, 0);
                    u32x2 o; o.x = pkbf(acc[0] * sc.x, acc[1] * sc.y); o.y = pkbf(acc[2] * sc.z, acc[3] * sc.w);
                    *(GAS u32x2*)(mix + (tokr + 16 * ti + fr) * D + AW + g * GD + 16 * dj + 4 * fq) = o;
                }
            }
        }
        __syncthreads();
    }
}
__device__ __forceinline__ void conv_phase(Frame& F, const float* w_dw, const float* b_dw, const float* ln_g, const float* ln_b) {
    const bf16* glu = (const bf16*)(F.ws + WS_GLU); bf16* cvo = (bf16*)(F.ws + WS_CV);
    int tid_l = F.tid; asm volatile("" : "+v"(tid_l)); const int tid = tid_l, lane = tid & 63, wave = __builtin_amdgcn_readfirstlane(tid >> 6); (void)tid; (void)lane; (void)wave;
    const int c0 = 2 * tid;
    LAS float* cv = (LAS float*)(F.lds + RING_OFF);
    f32x2 w[CONVK];
#pragma unroll
    for (int k = 0; k < CONVK; ++k) w[k] = *(const f32x2*)(w_dw + (size_t)k * D + c0);
    const f32x2 bd = *(const f32x2*)(b_dw + c0);
    for (int u = F.vcu; u < M / 16; u += F.G) {
        const int tok0 = u * 16; const bool hist = (tok0 & (SEQ - 1)) != 0;
        unsigned xin[46];
#pragma unroll
        for (int j = 0; j < 46; ++j) { const bool valid = (j >= 30) || hist; const size_t row = valid ? (size_t)(tok0 - 30 + j) : (size_t)tok0;
            const unsigned q = *(const GAS unsigned*)(glu + row * D + c0); xin[j] = valid ? q : 0u; }
        f32x2 acc[16];
#pragma unroll
        for (int i = 0; i < 16; ++i) acc[i] = bd;
#pragma unroll
        for (int j = 0; j < 46; ++j) { const f32x2 x = (f32x2){bf_lo(xin[j]), bf_hi(xin[j])};
#pragma unroll
            for (int i = 0; i < 16; ++i) if (j - i >= 0 && j - i <= 30) acc[i] += w[j - i] * x; }
#pragma unroll
        for (int i = 0; i < 16; ++i) *(LAS f32x2*)(cv + i * D + c0) = acc[i];
        __syncthreads();
#pragma unroll
        for (int rr = 0; rr < 2; ++rr) { const int row = 2 * wave + rr;
            f32x4 v[4]; float s = 0.f;
#pragma unroll
            for (int j = 0; j < 4; ++j) { v[j] = *(const LAS f32x4*)(cv + row * D + 4 * lane + 256 * j); s += (v[j].x + v[j].y) + (v[j].z + v[j].w); }
            const float mean = wave_sum(s) * (1.f / D); float s2 = 0.f;
#pragma unroll
            for (int j = 0; j < 4; ++j) { v[j] = v[j] - mean; s2 += dot4(v[j], v[j]); }
            const float rstd = 1.0f / sqrtf(wave_sum(s2) * (1.f / D) + EPS);
            GAS u32x2* o8 = (GAS u32x2*)(cvo + (size_t)(tok0 + row) * D) + lane;
#pragma unroll
            for (int j = 0; j < 4; ++j) { const f32x4 gg = *(const f32x4*)(ln_g + 4 * lane + 256 * j), bb = *(const f32x4*)(ln_b + 4 * lane + 256 * j);
                const f32x4 y = v[j] * rstd * gg + bb; u32x2 o; o.x = pkbf(silu_f(y.x), silu_f(y.y)); o.y = pkbf(silu_f(y.z), silu_f(y.w)); o8[64 * j] = o; } }
        __syncthreads();
    }
}
__device__ __forceinline__ void router_phase(Frame& F, const float* src, const float* gain, const float* w_router, bf16* dst, gu32* cnt) {
    int tid_l = F.tid; asm volatile("" : "+v"(tid_l)); const int tid = tid_l, lane = tid & 63, wave = __builtin_amdgcn_readfirstlane(tid >> 6); (void)tid; (void)lane; (void)wave;
    const int gw = F.vcu * NWAVES + wave, NGW = F.G * NWAVES;
    LAS float* wrT = (LAS float*)(F.lds + RING_OFF);
    LAS unsigned* lc = (LAS unsigned*)(F.lds + RING_OFF + 32768);
    for (int c = tid; c < D; c += NWAVES * 64) { const f32x4 a = *(const f32x4*)(w_router + (size_t)c * NEXP), b = *(const f32x4*)(w_router + (size_t)c * NEXP + 4);
        wrT[0 * D + c] = a.x; wrT[1 * D + c] = a.y; wrT[2 * D + c] = a.z; wrT[3 * D + c] = a.w; wrT[4 * D + c] = b.x; wrT[5 * D + c] = b.y; wrT[6 * D + c] = b.z; wrT[7 * D + c] = b.w; }
    if (tid < NEXP) lc[tid] = 0u;
    __syncthreads();
    f32x4 g[4];
#pragma unroll
    for (int j = 0; j < 4; ++j) g[j] = *(const f32x4*)(gain + 4 * lane + 256 * j);
    i32x4* tokinfo = (i32x4*)(F.ws + WS_TOKINFO);
    for (int m = gw; m < M; m += NGW) {
        const GAS f32x4* xr = (const GAS f32x4*)(src + (size_t)m * D) + lane;
        f32x4 v[4]; float s = 0.f;
#pragma unroll
        for (int j = 0; j < 4; ++j) { v[j] = xr[64 * j]; s += dot4(v[j], v[j]); }
        const float rstd = 1.0f / sqrtf(wave_sum(s) * (1.f / D) + EPS);
        GAS u32x2* o8 = (GAS u32x2*)(dst + (size_t)m * D) + lane;
#pragma unroll
        for (int j = 0; j < 4; ++j) { v[j] = v[j] * rstd * g[j]; u32x2 w; w.x = pkbf(v[j].x, v[j].y); w.y = pkbf(v[j].z, v[j].w); o8[64 * j] = w; }
        float lg[NEXP];
#pragma unroll
        for (int e = 0; e < NEXP; ++e) { float p = 0.f;
#pragma unroll
            for (int j = 0; j < 4; ++j) p += dot4(v[j], *(const LAS f32x4*)(wrT + e * D + 4 * lane + 256 * j));
            lg[e] = wave_sum(p); }
        int i1 = 0; float l1 = lg[0];
#pragma unroll
        for (int e = 1; e < NEXP; ++e) if (lg[e] > l1) { l1 = lg[e]; i1 = e; }
        int i2 = -1; float l2 = -INFINITY;
#pragma unroll
        for (int e = 0; e < NEXP; ++e) if (e != i1 && lg[e] > l2) { l2 = lg[e]; i2 = e; }
        const float g1 = 1.0f / (1.0f + __expf(l2 - l1)), g2 = 1.0f - g1;
        if (lane == 0) { tokinfo[m] = (i32x4){i1, i2, (int)__float_as_uint(g1), (int)__float_as_uint(g2)}; __hip_atomic_fetch_add(&lc[i1], 1u, __ATOMIC_RELAXED, __HIP_MEMORY_SCOPE_WORKGROUP); __hip_atomic_fetch_add(&lc[i2], 1u, __ATOMIC_RELAXED, __HIP_MEMORY_SCOPE_WORKGROUP); }
    }
    __syncthreads();
    if (tid < NEXP) __hip_atomic_fetch_add(cnt + 64 * tid, (unsigned)lc[tid], RLX_AGENT);
}
__device__ __forceinline__ void scatter_phase(Frame& F, gu32* cnt, gu32* cursor) {
    const bf16* hn = (const bf16*)(F.ws + WS_HN); bf16* hp = (bf16*)(F.ws + WS_HP);
    const i32x4* tokinfo = (const i32x4*)(F.ws + WS_TOKINFO); i32x2* tokslot = (i32x2*)(F.ws + WS_TOKSLOT); float* slotgate = (float*)(F.ws + WS_SLOTGATE);
    LAS int* pbase = (LAS int*)(F.lds + RING_OFF);
    LAS int* lcnt = pbase + 8;
    LAS int* base = pbase + 16;
    LAS int* sl = pbase + 32;
    int tid_l = F.tid; asm volatile("" : "+v"(tid_l)); const int tid = tid_l, lane = tid & 63, wave = __builtin_amdgcn_readfirstlane(tid >> 6); (void)tid; (void)lane; (void)wave;
    if (tid == 0) { int acc = 0;
#pragma unroll
        for (int e = 0; e < NEXP; ++e) { pbase[e] = acc * 256; acc += ((int)__hip_atomic_load(cnt + 64 * e, RLX_AGENT) + 255) >> 8; } }
    for (int u = F.vcu; u < M / 64; u += F.G) {
        const int tok0 = u * 64;
        if (tid < NEXP) lcnt[tid] = 0;
        __syncthreads();
        i32x4 info = (i32x4){0, 0, 0, 0}; int r1 = 0, r2 = 0;
        if (tid < 64) { info = tokinfo[tok0 + tid]; r1 = __hip_atomic_fetch_add(&lcnt[info.x], 1, __ATOMIC_RELAXED, __HIP_MEMORY_SCOPE_WORKGROUP); r2 = __hip_atomic_fetch_add(&lcnt[info.y], 1, __ATOMIC_RELAXED, __HIP_MEMORY_SCOPE_WORKGROUP); }
        __syncthreads();
        if (tid < NEXP) base[tid] = pbase[tid] + (int)__hip_atomic_fetch_add(cursor + 64 * tid, (unsigned)lcnt[tid], RLX_AGENT);
        __syncthreads();
        if (tid < 64) { const int s1 = base[info.x] + r1, s2 = base[info.y] + r2;
            tokslot[tok0 + tid] = (i32x2){s1, s2}; slotgate[s1] = __uint_as_float((unsigned)info.z); slotgate[s2] = __uint_as_float((unsigned)info.w);
            sl[2 * tid] = s1; sl[2 * tid + 1] = s2; }
        __syncthreads();
#pragma unroll 4
        for (int q = 0; q < 8; ++q) { const int tl = wave * 8 + q; const int s1 = sl[2 * tl], s2 = sl[2 * tl + 1];
            const GAS v4u* src = (const GAS v4u*)(hn + (size_t)(tok0 + tl) * D) + lane; const v4u a = src[0], b = src[64];
            GAS v4u* d1 = (GAS v4u*)(hp + (size_t)s1 * D) + lane; GAS v4u* d2 = (GAS v4u*)(hp + (size_t)s2 * D) + lane;
            d1[0] = a; d1[64] = b; d2[0] = a; d2[64] = b; }
        __syncthreads();
    }
}
__device__ __forceinline__ void combine_phase(Frame& F, float* h, const float* gain, bf16* dst, float* fout) {
    int tid_l = F.tid; asm volatile("" : "+v"(tid_l)); const int tid = tid_l, lane = tid & 63, wave = __builtin_amdgcn_readfirstlane(tid >> 6); (void)tid; (void)lane; (void)wave;
    const int gw = F.vcu * NWAVES + wave, NGW = F.G * NWAVES;
    const bf16* y = (const bf16*)(F.ws + WS_Y); const i32x2* tokslot = (const i32x2*)(F.ws + WS_TOKSLOT);
    f32x4 g[4];
#pragma unroll
    for (int j = 0; j < 4; ++j) g[j] = *(const f32x4*)(gain + 4 * lane + 256 * j);
    for (int m = gw; m < M; m += NGW) {
        const i32x2 ss = tokslot[m];
        GAS f32x4* xr = (GAS f32x4*)(h + (size_t)m * D) + lane;
        const GAS u32x2* y1 = (const GAS u32x2*)(y + (size_t)ss.x * D) + lane; const GAS u32x2* y2 = (const GAS u32x2*)(y + (size_t)ss.y * D) + lane;
        f32x4 v[4]; float s = 0.f;
#pragma unroll
        for (int j = 0; j < 4; ++j) { const u32x2 a = y1[64 * j], b = y2[64 * j]; v[j] = xr[64 * j];
            v[j].x += bf_lo(a.x) + bf_lo(b.x); v[j].y += bf_hi(a.x) + bf_hi(b.x); v[j].z += bf_lo(a.y) + bf_lo(b.y); v[j].w += bf_hi(a.y) + bf_hi(b.y);
            s += dot4(v[j], v[j]); }
        const float rstd = 1.0f / sqrtf(wave_sum(s) * (1.f / D) + EPS);
        if (fout) { GAS f32x4* o = (GAS f32x4*)(fout + (size_t)m * D) + lane;
#pragma unroll
            for (int j = 0; j < 4; ++j) o[64 * j] = v[j] * rstd * g[j]; }
        else { GAS u32x2* o8 = (GAS u32x2*)(dst + (size_t)m * D) + lane;
#pragma unroll
            for (int j = 0; j < 4; ++j) { xr[64 * j] = v[j]; const f32x4 yv = v[j] * rstd * g[j]; u32x2 w; w.x = pkbf(yv.x, yv.y); w.y = pkbf(yv.z, yv.w); o8[64 * j] = w; } }
    }
}

struct Args { const float* in[28]; float* out; unsigned char* ws; int ph_lo, ph_hi; };
#define PG8_ALIGN true
#define PG8_SP2 true
__global__ void __launch_bounds__(NWAVES * 64, 2) trunk_fwd(Args args) {
    extern __shared__ __attribute__((aligned(16))) unsigned char lds[];
    Frame F;
    F.lds = (LAS unsigned char*)lds;
    F.MISC = (volatile LAS unsigned*)(F.lds + MISC_OFF);
    F.tid = threadIdx.x; F.lane = F.tid & 63; F.wave = __builtin_amdgcn_readfirstlane(F.tid >> 6);
    F.G = gridDim.x; { const int bx = blockIdx.x; F.vcu = (F.G % 8 == 0) ? (bx % 8) * (F.G / 8) + bx / 8 : bx; }
    F.ws = args.ws; F.out = args.out; F.in = nullptr;
    F.ctl = (gu32*)(args.ws + WS_CTL);
    for (int u = F.tid; u < (LDS_BYTES - LDSCTL_OFF) / 4; u += NWAVES * 64) ((LAS unsigned*)(F.lds + LDSCTL_OFF))[u] = 0u;
    __syncthreads();
    XcdBarrier bar = xcd_barrier_post((unsigned*)(F.ctl + CW_BAR), F.MISC + 8);
    const float* const* kargs = (const float* const*)__builtin_amdgcn_kernarg_segment_ptr();
#define INP(k) ({ const float* const* p_ = kargs; asm volatile("" : "+s"(p_)); p_[k]; })
    const int lo = args.ph_lo, hi = args.ph_hi;
    int ph = 0;
#ifndef PHMASK
#define PHMASK 0xffff
#endif
#define EN(k) (((PHMASK) >> (k)) & 1)
#define RUN() (lo <= ph && ph < hi)
#define SEAM() do { if (lo <= ph && ph + 1 < hi) xcd_barrier(bar); ++ph; } while (0)
    unsigned char* const ws = args.ws;
    float* const H = (float*)(ws + WS_H); bf16* const HN = (bf16*)(ws + WS_HN);

    if (EN(0) && RUN()) { p0_prologue(F, kargs); rms_phase(F, INP(0), INP(1), HN); }
    SEAM();

#pragma unroll 1
    for (int li = 0; li < 2; ++li) {
        unsigned char* const we = ws + WS_WE + (size_t)li * WE_STRIDE; unsigned char* const wo = ws + WS_WO + (size_t)li * WO_STRIDE;
        if (EN(1) && RUN()) { pg8::Gemm g{HN, (const bf16*)(we + WE_IN), M, INE, D}; pg8::StaticOrder S; S.init(M, INE, F.G, (int)blockIdx.x);
            pg8::EpiGeluSplit E{(bf16*)(ws + WS_PROJ), INE, 4};
            pg8::gemm_phase<pg8::EpiGeluSplit, pg8::StaticOrder, PG8_ALIGN, PG8_SP2>(F.lds + RING_OFF, g, S, E); }
        SEAM();
        if (EN(2) && RUN()) mixer_phase(F, li, INP(3), INP(5), INP(7));
        SEAM();
        if (EN(3) && RUN()) { pg8::Gemm g{(const bf16*)(ws + WS_MIX), (const bf16*)(we + WE_OUT), M, D, D}; pg8::StaticOrder S; S.init(M, D, F.G, (int)blockIdx.x);
            pg8::EpiRes E{li == 0 ? INP(0) : (const float*)H, H, D, nullptr};
            pg8::gemm_phase<pg8::EpiRes, pg8::StaticOrder, PG8_ALIGN, PG8_SP2>(F.lds + RING_OFF, g, S, E); }
        SEAM();
        if (EN(4) && RUN()) rms_phase(F, H, INP(9) + li * D, HN);
        SEAM();
        if (EN(5) && RUN()) { pg8::Gemm g{HN, (const bf16*)(we + WE_GU), M, 2 * FFD, D}; pg8::StaticOrder S; S.init(M, 2 * FFD, F.G, (int)blockIdx.x);
            pg8::EpiGlu<0> E{(bf16*)(ws + WS_ACT), FFD, nullptr, nullptr};
            pg8::gemm_phase<pg8::EpiGlu<0>, pg8::StaticOrder, PG8_ALIGN, PG8_SP2>(F.lds + RING_OFF, g, S, E); }
        SEAM();
        if (EN(6) && RUN()) { pg8::Gemm g{(const bf16*)(ws + WS_ACT), (const bf16*)(we + WE_DN), M, D, FFD}; pg8::StaticOrder S; S.init(M, D, F.G, (int)blockIdx.x);
            pg8::EpiRes E{H, H, D, nullptr};
            pg8::gemm_phase<pg8::EpiRes, pg8::StaticOrder, PG8_ALIGN, PG8_SP2>(F.lds + RING_OFF, g, S, E); }
        SEAM();
        if (EN(7) && RUN()) rms_phase(F, H, INP(13) + li * D, HN);
        SEAM();
        if (EN(8) && RUN()) { pg8::Gemm g{HN, (const bf16*)(wo + WO_PW1), M, 2 * D, D}; pg8::StaticOrder S; S.init(M, 2 * D, F.G, (int)blockIdx.x);
            pg8::EpiGlu<1> E{(bf16*)(ws + WS_GLU), D, INP(15) + li * 2 * D, INP(15) + li * 2 * D + D};
            pg8::gemm_phase<pg8::EpiGlu<1>, pg8::StaticOrder, PG8_ALIGN, PG8_SP2>(F.lds + RING_OFF, g, S, E); }
        SEAM();
        if (EN(9) && RUN()) conv_phase(F, INP(16) + (size_t)li * CONVK * D, INP(17) + li * D, INP(18) + li * D, INP(19) + li * D);
        SEAM();
        if (EN(10) && RUN()) { pg8::Gemm g{(const bf16*)(ws + WS_CV), (const bf16*)(wo + WO_PW2), M, D, D}; pg8::StaticOrder S; S.init(M, D, F.G, (int)blockIdx.x);
            pg8::EpiRes E{H, H, D, INP(21) + li * D};
            pg8::gemm_phase<pg8::EpiRes, pg8::StaticOrder, PG8_ALIGN, PG8_SP2>(F.lds + RING_OFF, g, S, E); }
        SEAM();
        gu32* const cnt = F.ctl + CW_MOE + li * 1024; gu32* const cursor = cnt + 512;
        if (EN(11) && RUN()) router_phase(F, H, INP(22) + li * D, INP(23) + (size_t)li * D * NEXP, HN, cnt);
        SEAM();
        if (EN(12) && RUN()) scatter_phase(F, cnt, cursor);
        SEAM();
        if (EN(13) && RUN()) { pg8::GroupedOrder S; { int acc = 0; S.ts[0] = 0;
#pragma unroll
                for (int e = 0; e < NEXP; ++e) { const int c = __builtin_amdgcn_readfirstlane((int)__hip_atomic_load(cnt + 64 * e, RLX_AGENT)); acc += (c + 255) >> 8; S.ts[e + 1] = acc; }
                S.nM = acc; S.nN = 2 * FFX / 256; S.nwg = acc * S.nN; S.G = F.G; S.c = (int)blockIdx.x; }
            pg8::Gemm g{(const bf16*)(ws + WS_HP), (const bf16*)(wo + WO_GUX), MSLOT, 2 * FFX, D};
            pg8::EpiGlu<0> E{(bf16*)(ws + WS_ACTX), FFX, nullptr, nullptr};
            pg8::gemm_phase<pg8::EpiGlu<0>, pg8::GroupedOrder, PG8_ALIGN, PG8_SP2>(F.lds + RING_OFF, g, S, E); }
        SEAM();
        if (EN(14) && RUN()) { pg8::GroupedOrder S; { int acc = 0; S.ts[0] = 0;
#pragma unroll
                for (int e = 0; e < NEXP; ++e) { const int c = __builtin_amdgcn_readfirstlane((int)__hip_atomic_load(cnt + 64 * e, RLX_AGENT)); acc += (c + 255) >> 8; S.ts[e + 1] = acc; }
                S.nM = acc; S.nN = D / 256; S.nwg = acc * S.nN; S.G = F.G; S.c = (int)blockIdx.x; }
            pg8::Gemm g{(const bf16*)(ws + WS_ACTX), (const bf16*)(wo + WO_DNX), MSLOT, D, FFX};
            pg8::EpiScale E{(bf16*)(ws + WS_Y), D, (const float*)(ws + WS_SLOTGATE)};
            pg8::gemm_phase<pg8::EpiScale, pg8::GroupedOrder, PG8_ALIGN, PG8_SP2>(F.lds + RING_OFF, g, S, E); }
        SEAM();
        if (EN(15) && RUN()) combine_phase(F, H, li == 0 ? INP(1) + D : INP(27), HN, li == 0 ? nullptr : args.out);
        SEAM();
    }
#undef RUN
#undef SEAM
}

extern "C" void kernel_launch(void* const* d_in, const int* in_sizes, int n_in, void* d_out, int out_size, void* d_ws, size_t ws_size, hipStream_t stream) {
    static int grid = 0;
    if (grid == 0) {
        if (n_in != 28 || in_sizes[0] != M * D || out_size != M * D || ws_size < WS_END) { fprintf(stderr, "kernel_launch: shape/workspace mismatch (n_in %d, in0 %d, out %d, ws %zu, need %zu); nothing launched\n", n_in, n_in > 0 ? in_sizes[0] : -1, out_size, ws_size, (size_t)WS_END); grid = -1; return; }
        int dev = 0, cus = 0, per_cu = 0;
        if (hipGetDevice(&dev) != hipSuccess || hipDeviceGetAttribute(&cus, hipDeviceAttributeMultiprocessorCount, dev) != hipSuccess) { grid = -1; return; }
        if (hipFuncSetAttribute((const void*)trunk_fwd, hipFuncAttributeMaxDynamicSharedMemorySize, LDS_BYTES) != hipSuccess) { fprintf(stderr, "kernel_launch: hipFuncSetAttribute failed\n"); grid = -1; return; }
        if (hipOccupancyMaxActiveBlocksPerMultiprocessor(&per_cu, (const void*)trunk_fwd, NWAVES * 64, LDS_BYTES) != hipSuccess || per_cu < 1)
            fprintf(stderr, "kernel_launch: note: occupancy query reports %d workgroups per CU\n", per_cu);
        (void)hipGetLastError();
        grid = cus;
    }
    if (grid < 0) return;
    if (hipMemsetAsync((char*)d_ws + WS_CTL, 0, CTL_ZERO_BYTES, stream) != hipSuccess) { fprintf(stderr, "kernel_launch: hipMemsetAsync failed\n"); return; }
    Args a{};
    for (int i = 0; i < 28; ++i) a.in[i] = (const float*)d_in[i];
    a.out = (float*)d_out; a.ws = (unsigned char*)d_ws;
#if MK_PER_PHASE
    for (int p = 0; p < NPH; ++p) { a.ph_lo = p; a.ph_hi = p + 1; hipLaunchKernelGGL(trunk_fwd, dim3(grid), dim3(NWAVES * 64), LDS_BYTES, stream, a); }
#else
    a.ph_lo = 0; a.ph_hi = NPH;
    hipLaunchKernelGGL(trunk_fwd, dim3(grid), dim3(NWAVES * 64), LDS_BYTES, stream, a);
#endif
    const hipError_t le = hipPeekAtLastError();
    if (le != hipSuccess) fprintf(stderr, "kernel_launch: launch failed: %s\n", hipGetErrorName(le));
}
```

```cpp
#include <hip/hip_runtime.h>
#include <cstdio>
#include <cstdint>
#include <cmath>
#ifndef MK_PER_PHASE
#define MK_PER_PHASE 0
#endif
namespace pg8 {
#define PG8_LAS __attribute__((address_space(3)))
typedef unsigned short bf16_t;
typedef short bf16x8 __attribute__((ext_vector_type(8)));
typedef float f32x4 __attribute__((ext_vector_type(4)));
typedef unsigned u32x4 __attribute__((ext_vector_type(4)));
constexpr int BM = 256, BK = 64, HALF = 128, HTB = HALF * BK * 2  , STAGE_BYTES = 8 * HTB, NXCD = 8, WGM = 8;

__host__ __device__ __forceinline__ int lds_byte(int r, int c) { const int st = (r >> 4) * 2 + (c >> 5), rr = r & 15, cc = c & 31, ob = rr * 64 + cc * 2; return st * 1024 + (ob ^ (((ob >> 9) & 1) << 5)); }
__host__ __device__ __forceinline__ void stage_rc(int b, int& R, int& C) { const int st = b / 1024, sb = b % 1024, swz = sb ^ (((sb >> 9) & 1) << 5); R = (st >> 1) * 16 + swz / 64; C = (st & 1) * 32 + (swz % 64) / 2; }
__host__ __device__ __forceinline__ int perm32(int rho) { const int n = rho >> 4, i = rho & 15; return 8 * (i >> 2) + 4 * n + (i & 3); }

struct Unit { int pm, pn, pb; };
struct Gemm { const bf16_t* A; const bf16_t* Bt; int M, N, K; };

struct StaticOrder {
    int nM, nN, nwg, G, c;
    __host__ __device__ void init(int M, int N, int G_, int c_) { nM = M / BM; nN = N / BM; nwg = nM * nN; G = G_; c = c_; }
    __host__ __device__ bool next(int i, Unit& u) const {
        const long L = (long)i * G + c; if (L >= nwg) return false;
        int wgid = (int)L; { const int q = nwg / NXCD, r = nwg % NXCD, xcd = wgid % NXCD, off = wgid / NXCD; wgid = (xcd < r ? xcd * (q + 1) : r * (q + 1) + (xcd - r) * q) + off; }
        const int nig = WGM * nN, gid = wgid / nig, fm = gid * WGM, gsz = (nM - fm) < WGM ? (nM - fm) : WGM;
        u.pm = fm + ((wgid % nig) % gsz); u.pn = (wgid % nig) / gsz; u.pb = u.pn; return true;
    }
    __device__ __forceinline__ void a_ready(const Unit&) const {}
    __device__ __forceinline__ void done(const Unit&) const {}
};


struct GroupedOrder {
    int nM, nN, nwg, G, c; int ts[9];
    __device__ __forceinline__ bool next(int i, Unit& u) const {
        const long L = (long)i * G + c; if (L >= nwg) return false;
        int wgid = (int)L; { const int q = nwg / NXCD, r = nwg % NXCD, xcd = wgid % NXCD, off = wgid / NXCD; wgid = (xcd < r ? xcd * (q + 1) : r * (q + 1) + (xcd - r) * q) + off; }
        const int nig = WGM * nN, gid = wgid / nig, fm = gid * WGM, gsz = (nM - fm) < WGM ? (nM - fm) : WGM;
        u.pm = fm + ((wgid % nig) % gsz); u.pn = (wgid % nig) / gsz;
        int e = 0;
#pragma unroll
        for (int j = 1; j < 8; ++j) e += (u.pm >= ts[j]) ? 1 : 0;
        u.pb = e * nN + u.pn; return true;
    }
    __device__ __forceinline__ void a_ready(const Unit&) const {}
    __device__ __forceinline__ void done(const Unit&) const {}
};

__device__ __forceinline__ unsigned cvt_pk_bf16(float lo, float hi) { unsigned r; asm volatile("v_cvt_pk_bf16_f32 %0, %1, %2" : "=v"(r) : "v"(lo), "v"(hi)); return r; }
__device__ __forceinline__ float fast_sigmoid(float x) { return __builtin_amdgcn_rcpf(1.0f + __builtin_amdgcn_exp2f(x * -1.4426950408889634f)); }
__device__ __forceinline__ float gelu_tanh(float x) {
    const float t = x * (1.0f + 0.044715f * x * x);
    return x * __builtin_amdgcn_rcpf(1.0f + __builtin_amdgcn_exp2f(t * -2.3022081986f));
}
__device__ __forceinline__ f32x4 gelu4(f32x4 v) { return (f32x4){gelu_tanh(v[0]), gelu_tanh(v[1]), gelu_tanh(v[2]), gelu_tanh(v[3])}; }

struct EpiGeluSplit {
    static constexpr bool PERM = true, AFTER_DRAIN = false;
    bf16_t* O; int ldc; int gelu_tiles;
    __device__ __forceinline__ void operator()(const f32x4 (&acc)[2][2][4][2], const Unit& u, int wr, int wc, int fr, int fq) const {
        const int row0 = u.pm * BM + wr * 64 + fr, col0 = u.pn * BM + wc * 32 + 8 * fq;
        const bool act = u.pn < gelu_tiles;
#pragma unroll
        for (int ai = 0; ai < 2; ++ai)
#pragma unroll
            for (int m = 0; m < 4; ++m) { bf16_t* rowp = O + (size_t)(row0 + ai * HALF + m * 16) * ldc + col0;
#pragma unroll
                for (int bj = 0; bj < 2; ++bj) { f32x4 v0 = acc[ai][bj][m][0], v1 = acc[ai][bj][m][1];
                    if (act) { v0 = gelu4(v0); v1 = gelu4(v1); }
                    u32x4 w; w.x = cvt_pk_bf16(v0[0], v0[1]); w.y = cvt_pk_bf16(v0[2], v0[3]); w.z = cvt_pk_bf16(v1[0], v1[1]); w.w = cvt_pk_bf16(v1[2], v1[3]);
                    *(u32x4*)(rowp + bj * HALF) = w; } }
    }
};
struct EpiRes {
    static constexpr bool PERM = false, AFTER_DRAIN = false;
    const float* base; float* out; int ldc; const float* bias;
    __device__ __forceinline__ void operator()(const f32x4 (&acc)[2][2][4][2], const Unit& u, int wr, int wc, int fr, int fq) const {
        const int row0 = u.pm * BM + wr * 64 + fr, col0 = u.pn * BM + wc * 32 + 4 * fq;
        f32x4 bv[2][2];
#pragma unroll
        for (int bj = 0; bj < 2; ++bj)
#pragma unroll
            for (int n = 0; n < 2; ++n) bv[bj][n] = bias ? *(const f32x4*)(bias + col0 + bj * HALF + n * 16) : (f32x4){0.f, 0.f, 0.f, 0.f};
#pragma unroll
        for (int ai = 0; ai < 2; ++ai)
#pragma unroll
            for (int m = 0; m < 4; ++m) { const size_t off = (size_t)(row0 + ai * HALF + m * 16) * ldc + col0;
#pragma unroll
                for (int bj = 0; bj < 2; ++bj)
#pragma unroll
                    for (int n = 0; n < 2; ++n) { const f32x4 bs = *(const f32x4*)(base + off + bj * HALF + n * 16);
                        *(f32x4*)(out + off + bj * HALF + n * 16) = bs + acc[ai][bj][m][n] + bv[bj][n]; } }
    }
};
template <int MODE> struct EpiGlu {
    static constexpr bool PERM = true, AFTER_DRAIN = false;
    bf16_t* O; int ldo; const float* bias0; const float* bias1;
    __device__ __forceinline__ void operator()(const f32x4 (&acc)[2][2][4][2], const Unit& u, int wr, int wc, int fr, int fq) const {
        const int row0 = u.pm * BM + wr * 64 + fr, ocol = u.pn * HALF + wc * 32 + 8 * fq;
        f32x4 b0[2], b1[2];
#pragma unroll
        for (int n = 0; n < 2; ++n) { b0[n] = (MODE == 1) ? *(const f32x4*)(bias0 + ocol + 4 * n) : (f32x4){0.f, 0.f, 0.f, 0.f}; b1[n] = (MODE == 1) ? *(const f32x4*)(bias1 + ocol + 4 * n) : (f32x4){0.f, 0.f, 0.f, 0.f}; }
#pragma unroll
        for (int ai = 0; ai < 2; ++ai)
#pragma unroll
            for (int m = 0; m < 4; ++m) { bf16_t* rowp = O + (size_t)(row0 + ai * HALF + m * 16) * ldo + ocol;
                f32x4 r[2];
#pragma unroll
                for (int n = 0; n < 2; ++n) { const f32x4 a = acc[ai][0][m][n] + b0[n], b = acc[ai][1][m][n] + b1[n];
#pragma unroll
                    for (int i = 0; i < 4; ++i) r[n][i] = (MODE == 0) ? (a[i] * fast_sigmoid(a[i]) * b[i]) : (a[i] * fast_sigmoid(b[i])); }
                u32x4 w; w.x = cvt_pk_bf16(r[0][0], r[0][1]); w.y = cvt_pk_bf16(r[0][2], r[0][3]); w.z = cvt_pk_bf16(r[1][0], r[1][1]); w.w = cvt_pk_bf16(r[1][2], r[1][3]);
                *(u32x4*)rowp = w; }
    }
};
struct EpiScale {
    static constexpr bool PERM = true, AFTER_DRAIN = false;
    bf16_t* O; int ldc; const float* rowscale;
    __device__ __forceinline__ void operator()(const f32x4 (&acc)[2][2][4][2], const Unit& u, int wr, int wc, int fr, int fq) const {
        const int row0 = u.pm * BM + wr * 64 + fr, col0 = u.pn * BM + wc * 32 + 8 * fq;
#pragma unroll
        for (int ai = 0; ai < 2; ++ai)
#pragma unroll
            for (int m = 0; m < 4; ++m) { const int row = row0 + ai * HALF + m * 16; const float s = rowscale[row]; bf16_t* rowp = O + (size_t)row * ldc + col0;
#pragma unroll
                for (int bj = 0; bj < 2; ++bj) { const f32x4 v0 = acc[ai][bj][m][0] * s, v1 = acc[ai][bj][m][1] * s;
                    u32x4 w; w.x = cvt_pk_bf16(v0[0], v0[1]); w.y = cvt_pk_bf16(v0[2], v0[3]); w.z = cvt_pk_bf16(v1[0], v1[1]); w.w = cvt_pk_bf16(v1[2], v1[3]);
                    *(u32x4*)(rowp + bj * HALF) = w; } }
    }
};

template <class Epi, class Sched, bool ALIGN_EPI = false, bool SP2 = false>
__device__ __forceinline__ void gemm_phase(PG8_LAS unsigned char* lds, const Gemm g, const Sched& S, const Epi& E) {
    int tid_l = threadIdx.x; asm volatile("" : "+v"(tid_l));
    const int tid = tid_l, wid = __builtin_amdgcn_readfirstlane(tid >> 6), lane = tid & 63, wr = wid >> 2, wc = wid & 3, fr = lane & 15, fq = lane >> 4;
    const int K = g.K, nt = K / BK;
    unsigned voffA[2], voffB[2];
#pragma unroll
    for (int i = 0; i < 2; ++i) { int R, C; stage_rc(tid * 16 + i * 8192, R, C); const int Rb = Epi::PERM ? ((R & ~31) + perm32(R & 31)) : R;
        voffA[i] = (unsigned)(R * K + C) * 2u; voffB[i] = (unsigned)(Rb * K + C) * 2u; }
    const size_t kstep = (size_t)(BK * 2);
    const size_t hstep = (size_t)HALF * K * 2;
    const size_t tstep = 2 * hstep;
    const unsigned ldsw = (unsigned)wid * 1024u;
    const int aoff = lds_byte(wr * 64 + fr, fq * 8), boff = lds_byte(wc * 32 + fr, fq * 8);
#define PG8_SA(b, h) (((b) * 2 + (h)) * HTB)
#define PG8_SB(b, h) ((4 + (b) * 2 + (h)) * HTB)
#define PG8_STAGE(bufoff, gbase, voff) do { _Pragma("unroll") for (int _i = 0; _i < 2; ++_i) \
        __builtin_amdgcn_global_load_lds((const unsigned*)((const char*)(gbase) + (voff)[_i]), (PG8_LAS unsigned*)(lds + (bufoff) + ldsw + _i * 8192), 16, 0, 0); } while (0)
#define PG8_LDA(dst, b, h) do { _Pragma("unroll") for (int m = 0; m < 4; ++m) _Pragma("unroll") for (int k = 0; k < 2; ++k) dst[m][k] = *(const PG8_LAS bf16x8*)(lds + PG8_SA(b, h) + aoff + m * 2048 + k * 1024); } while (0)
#define PG8_LDB(dst, b, h) do { _Pragma("unroll") for (int n = 0; n < 2; ++n) _Pragma("unroll") for (int k = 0; k < 2; ++k) dst[n][k] = *(const PG8_LAS bf16x8*)(lds + PG8_SB(b, h) + boff + n * 2048 + k * 1024); } while (0)
#define PG8_MMA(ai, bj, At, Bt) do { __builtin_amdgcn_s_setprio(1); _Pragma("unroll") for (int m = 0; m < 4; ++m) _Pragma("unroll") for (int n = 0; n < 2; ++n) _Pragma("unroll") for (int k = 0; k < 2; ++k) \
        acc[ai][bj][m][n] = __builtin_amdgcn_mfma_f32_16x16x32_bf16(Bt[n][k], At[m][k], acc[ai][bj][m][n], 0, 0, 0); __builtin_amdgcn_s_setprio(0); } while (0)
#define PG8_WAIT_V(n) asm volatile("s_waitcnt vmcnt(" #n ")" ::: "memory")
#define PG8_WAIT_L(n) asm volatile("s_waitcnt lgkmcnt(" #n ")" ::: "memory")
#define PG8_BAR __builtin_amdgcn_s_barrier()
#define PG8_SCHED __builtin_amdgcn_sched_barrier(0)
    Unit cur, nxt; int ui = 0;
    if (!S.next(0, cur)) return;
    f32x4 acc[2][2][4][2];
#pragma unroll
    for (int a = 0; a < 2; ++a)
#pragma unroll
        for (int b = 0; b < 2; ++b)
#pragma unroll
            for (int m = 0; m < 4; ++m)
#pragma unroll
                for (int n = 0; n < 2; ++n) acc[a][b][m][n] = (f32x4){0.f, 0.f, 0.f, 0.f};
    bf16x8 At[4][2], B0[2][2], B1[2][2];
    const char* cA = (const char*)g.A + (size_t)cur.pm * tstep; const char* cB = (const char*)g.Bt + (size_t)cur.pb * tstep;
    S.a_ready(cur);
    if constexpr (SP2) {
        PG8_STAGE(PG8_SB(0, 0), cB, voffB); PG8_STAGE(PG8_SB(0, 1), cB + hstep, voffB); PG8_STAGE(PG8_SA(0, 0), cA, voffA); PG8_STAGE(PG8_SA(0, 1), cA + hstep, voffA);
        if (wr == 1) PG8_BAR;
        PG8_WAIT_V(2); PG8_BAR;
        PG8_STAGE(PG8_SB(1, 0), cB + kstep, voffB); PG8_STAGE(PG8_SA(1, 0), cA + kstep, voffA); PG8_STAGE(PG8_SB(1, 1), cB + hstep + kstep, voffB);
        PG8_WAIT_V(6); PG8_BAR;
    } else {
        PG8_STAGE(PG8_SB(0, 0), cB, voffB); PG8_STAGE(PG8_SA(0, 0), cA, voffA); PG8_STAGE(PG8_SB(0, 1), cB + hstep, voffB); PG8_STAGE(PG8_SA(0, 1), cA + hstep, voffA);
        if (wr == 1) PG8_BAR;
        PG8_WAIT_V(4); PG8_BAR;
        PG8_STAGE(PG8_SB(1, 0), cB + kstep, voffB); PG8_STAGE(PG8_SA(1, 0), cA + kstep, voffA); PG8_STAGE(PG8_SB(1, 1), cB + hstep + kstep, voffB);
        PG8_WAIT_V(6); PG8_BAR;
    }
    for (;;) {
        const bool has_next = S.next(ui + 1, nxt);
        const char* nA = has_next ? (const char*)g.A + (size_t)nxt.pm * tstep : cA; const char* nB = has_next ? (const char*)g.Bt + (size_t)nxt.pb * tstep : cB;
        for (int t = 0; t < nt; t += 2) {
            const bool last = (t == nt - 2);
            const char* a1 = cA + (size_t)(t + 1) * kstep;
            const char* a2 = last ? nA : cA + (size_t)(t + 2) * kstep; const char* b2 = last ? nB : cB + (size_t)(t + 2) * kstep;
            const char* a3 = a2 + kstep; const char* b3 = b2 + kstep;
            if (last && has_next) S.a_ready(nxt);
            if constexpr (SP2) {
            PG8_LDB(B0, 0, 0); PG8_LDB(B1, 0, 1); PG8_SCHED; PG8_LDA(At, 0, 0); PG8_STAGE(PG8_SA(1, 1), a1 + hstep, voffA);
            PG8_WAIT_V(8); PG8_WAIT_L(0); PG8_BAR; PG8_MMA(0, 0, At, B0); PG8_MMA(0, 1, At, B1); PG8_BAR; PG8_SCHED;
            PG8_LDA(At, 0, 1); PG8_STAGE(PG8_SB(0, 0), b2, voffB); PG8_STAGE(PG8_SB(0, 1), b2 + hstep, voffB); PG8_STAGE(PG8_SA(0, 0), a2, voffA);
            PG8_WAIT_V(8); PG8_WAIT_L(0); PG8_BAR; PG8_MMA(1, 0, At, B0); PG8_MMA(1, 1, At, B1); PG8_BAR; PG8_SCHED;
            PG8_LDB(B0, 1, 0); PG8_LDB(B1, 1, 1); PG8_SCHED; PG8_LDA(At, 1, 0); PG8_STAGE(PG8_SA(0, 1), a2 + hstep, voffA);
            PG8_WAIT_V(8); PG8_WAIT_L(0); PG8_BAR; PG8_MMA(0, 0, At, B0); PG8_MMA(0, 1, At, B1); PG8_BAR; PG8_SCHED;
            PG8_LDA(At, 1, 1); PG8_STAGE(PG8_SB(1, 0), b3, voffB); PG8_STAGE(PG8_SB(1, 1), b3 + hstep, voffB); PG8_STAGE(PG8_SA(1, 0), a3, voffA);
            PG8_WAIT_V(8); PG8_WAIT_L(0); PG8_BAR; PG8_MMA(1, 0, At, B0); PG8_MMA(1, 1, At, B1); PG8_BAR; PG8_SCHED;
            } else {
            PG8_LDB(B0, 0, 0); PG8_SCHED; PG8_LDA(At, 0, 0); PG8_STAGE(PG8_SA(1, 1), a1 + hstep, voffA);
            PG8_WAIT_L(8); PG8_BAR; PG8_WAIT_L(0); PG8_MMA(0, 0, At, B0); PG8_BAR; PG8_SCHED;
            PG8_LDB(B1, 0, 1); PG8_STAGE(PG8_SB(0, 0), b2, voffB);
            PG8_BAR; PG8_WAIT_L(0); PG8_MMA(0, 1, At, B1); PG8_BAR;
            PG8_LDA(At, 0, 1); PG8_STAGE(PG8_SA(0, 0), a2, voffA);
            PG8_BAR; PG8_WAIT_L(0); PG8_MMA(1, 0, At, B0); PG8_BAR; PG8_SCHED;
            PG8_STAGE(PG8_SB(0, 1), b2 + hstep, voffB);
            PG8_WAIT_V(6); PG8_BAR; PG8_MMA(1, 1, At, B1); PG8_BAR;
            PG8_LDB(B0, 1, 0); PG8_SCHED; PG8_LDA(At, 1, 0); PG8_STAGE(PG8_SA(0, 1), a2 + hstep, voffA);
            PG8_WAIT_L(8); PG8_BAR; PG8_WAIT_L(0); PG8_MMA(0, 0, At, B0); PG8_BAR; PG8_SCHED;
            PG8_LDB(B1, 1, 1); PG8_STAGE(PG8_SB(1, 0), b3, voffB);
            PG8_BAR; PG8_WAIT_L(0); PG8_MMA(0, 1, At, B1); PG8_BAR;
            PG8_LDA(At, 1, 1); PG8_STAGE(PG8_SA(1, 0), a3, voffA);
            PG8_BAR; PG8_WAIT_L(0); PG8_MMA(1, 0, At, B0); PG8_BAR; PG8_SCHED;
            PG8_STAGE(PG8_SB(1, 1), b3 + hstep, voffB);
            PG8_WAIT_V(6); PG8_BAR; PG8_MMA(1, 1, At, B1); PG8_BAR;
            }
        }
        if constexpr (ALIGN_EPI) { if (wr == 0) PG8_BAR; }
        if constexpr (!Epi::AFTER_DRAIN) { E(acc, cur, wr, wc, fr, fq); S.done(cur); }
        if (!has_next) break;
#pragma unroll
        for (int a = 0; a < 2; ++a)
#pragma unroll
            for (int b = 0; b < 2; ++b)
#pragma unroll
                for (int m = 0; m < 4; ++m)
#pragma unroll
                    for (int n = 0; n < 2; ++n) acc[a][b][m][n] = (f32x4){0.f, 0.f, 0.f, 0.f};
        cur = nxt; cA = nA; cB = nB; ++ui;
        if constexpr (ALIGN_EPI) { if (wr == 1) PG8_BAR; }
    }
    PG8_WAIT_V(0);
    if constexpr (!ALIGN_EPI) { if (wr == 0) PG8_BAR; }
    PG8_BAR;
    if constexpr (Epi::AFTER_DRAIN) { E.fused(acc, cur, wr, wc, fr, fq, lds, wid, lane); S.done(cur); }
#undef PG8_SA
#undef PG8_SB
#undef PG8_STAGE
#undef PG8_LDA
#undef PG8_LDB
#undef PG8_MMA
#undef PG8_WAIT_V
#undef PG8_WAIT_L
#undef PG8_BAR
#undef PG8_SCHED
}
}

constexpr int NWAVES = 8;
#ifndef MK_PER_PHASE
#define MK_PER_PHASE 0
#endif

constexpr int BATCH = 4, SEQ = 4096, D = 1024, M = BATCH * SEQ;
constexpr int INE = 1536, AW = 512, NHEAD = 8, HD = 64, CHUNK = 128, BW = 512, NGRP = 4, GD = 128;
constexpr int FFD = 2816, NEXP = 8, FFX = 3584, CONVK = 31;
constexpr float EPS = 1e-6f;
constexpr int MSLOT = 2 * M + NEXP * 256;
constexpr int NPH = 31;

constexpr size_t MiB = 1u << 20;
constexpr size_t WS_CTL = 0, CTL_ZERO_BYTES = 1 * MiB;
constexpr size_t WS_WE = 1 * MiB, WE_STRIDE = 23 * MiB;
constexpr size_t WE_IN = 0, WE_OUT = 3 * MiB, WE_GU = 5 * MiB, WE_DN = 16 * MiB, WE_SP = 21 * MiB + 512 * 1024, WE_PL = 21 * MiB + 768 * 1024;
constexpr size_t WS_WO = 47 * MiB, WO_STRIDE = 174 * MiB;
constexpr size_t WO_PW1 = 0, WO_PW2 = 4 * MiB, WO_GUX = 6 * MiB, WO_DNX = 118 * MiB;
constexpr size_t WS_H = 395 * MiB;
constexpr size_t WS_HN = 459 * MiB;
constexpr size_t WS_R = 491 * MiB;
constexpr size_t WS_PROJ = WS_R, WS_MIX = WS_R + 48 * MiB, WS_ACT = WS_R + 80 * MiB;
constexpr size_t WS_GLU = WS_R, WS_CV = WS_R + 32 * MiB;
constexpr size_t WS_HP = WS_R, WS_ACTX = WS_R + 68 * MiB, WS_Y = WS_R + 306 * MiB;
constexpr size_t WS_TOKINFO = 865 * MiB, WS_TOKSLOT = WS_TOKINFO + 256 * 1024, WS_SLOTGATE = WS_TOKSLOT + 128 * 1024, WS_END = 866 * MiB;
static_assert(WS_WE + 2 * WE_STRIDE <= WS_WO && WS_WO + 2 * WO_STRIDE <= WS_H && WS_H + (size_t)M * D * 4 <= WS_HN && WS_HN + (size_t)M * D * 2 <= WS_R, "ws map");
static_assert(WS_ACT + (size_t)M * FFD * 2 <= WS_TOKINFO && WS_ACTX + (size_t)MSLOT * FFX * 2 <= WS_Y && WS_Y + (size_t)MSLOT * D * 2 <= WS_TOKINFO && (size_t)MSLOT * D * 2 <= 68 * MiB, "ws map 2");
static_assert(WS_SLOTGATE + (size_t)MSLOT * 4 <= WS_END && WS_END <= 896 * MiB, "ws map 3");
constexpr int CW_TMO = 0, CW_CODE = 1;
constexpr int CW_BAR = 4096;
constexpr int CW_MOE = 8192;

constexpr int RING_OFF = 0, RING_BYTES = 141312;
constexpr int LDSCTL_OFF = RING_BYTES, MISC_OFF = LDSCTL_OFF + 320;
constexpr int LDS_BYTES = 147456;
static_assert(MISC_OFF + 128 <= LDS_BYTES, "LDS map");

#define GAS __attribute__((address_space(1)))
#define LAS __attribute__((address_space(3)))
typedef unsigned short bf16;
typedef unsigned v4u __attribute__((ext_vector_type(4)));
typedef float f32x4 __attribute__((ext_vector_type(4)));
typedef short bf16x8 __attribute__((ext_vector_type(8)));
typedef GAS unsigned gu32;
typedef GAS unsigned long long gu64;
#define RLX_AGENT __ATOMIC_RELAXED, __HIP_MEMORY_SCOPE_AGENT
#define LDS_WAIT() asm volatile("s_waitcnt lgkmcnt(0)" ::: "memory")
#define VM_WAIT() asm volatile("s_waitcnt vmcnt(0)" ::: "memory")
__device__ __forceinline__ unsigned long long rt() { return __builtin_amdgcn_s_memrealtime(); }
__device__ __forceinline__ unsigned f2bf(float f) { unsigned u = __builtin_bit_cast(unsigned, f); return (u + 0x7fffu + ((u >> 16) & 1u)) >> 16; }
__device__ __forceinline__ unsigned pk2(float lo, float hi) { return f2bf(lo) | (f2bf(hi) << 16); }

#define XB_TMO      128
#define XB_XCNT(j)  (256  + 64 * (j))
#define XB_XSUB(j)  (1280 + 64 * (j))
#define XB_XGEN(j)  (2304 + 64 * (j))
#define XB_TOP      3328
#define XB_TOPGEN   3392
#define XCD_BAR_WORDS 3456
#define XB_SPIN_CAP (1u << 18)

__device__ __forceinline__ unsigned xb_ld(unsigned* p)              { return __hip_atomic_load(p, __ATOMIC_RELAXED, __HIP_MEMORY_SCOPE_AGENT); }
__device__ __forceinline__ unsigned xb_add(unsigned* p, unsigned v) { return __hip_atomic_fetch_add(p, v, __ATOMIC_RELAXED, __HIP_MEMORY_SCOPE_AGENT); }
__device__ __forceinline__ unsigned xb_xcc_id() { return (unsigned)__builtin_amdgcn_s_getreg((3 << 11) | 20) & 0xFu; }
#define XB_SPIN(cond, bar) do { unsigned _sp = 0; while (cond) { __builtin_amdgcn_s_sleep(1); \
    if ((++_sp & 255u) == 0u) { if (xb_ld(&(bar)[XB_TMO])) break; if (_sp > XB_SPIN_CAP) { atomicAdd(&(bar)[XB_TMO], 1u); break; } } } } while (0)

struct XcdBarrier {
    unsigned* bar; unsigned x;
    volatile LAS unsigned* st;
};

__device__ __forceinline__ XcdBarrier xcd_barrier_post(unsigned* bar, volatile LAS unsigned* st) {
    XcdBarrier b; b.bar = bar; b.x = xb_xcc_id(); b.st = st;
    if (threadIdx.x == 0) (void)xb_add(&bar[XB_XCNT(b.x)], 1u);
    return b;
}
__device__ __forceinline__ void xcd_barrier_complete(unsigned* bar, unsigned x, unsigned& nloc, unsigned& nx) {
    const unsigned G = gridDim.x * gridDim.y * gridDim.z;
    unsigned sum, cnt, mine, sp = 0u;
    for (;;) {
        sum = 0u; cnt = 0u; mine = 0u;
#pragma unroll 1
        for (unsigned j = 0; j < 16; ++j) { const unsigned c = xb_ld(&bar[XB_XCNT(j)]); sum += c; cnt += (c > 0u) ? 1u : 0u; mine = (j == x) ? c : mine; }
        if (sum == G) break;
        __builtin_amdgcn_s_sleep(1);
        if ((++sp & 255u) == 0u) { if (xb_ld(&bar[XB_TMO])) break; if (sp > XB_SPIN_CAP) { atomicAdd(&bar[XB_TMO], 1u); break; } }
    }
    nloc = mine > 0u ? mine : 1u; nx = cnt > 0u ? cnt : 1u;
}

__device__ __forceinline__ void xcd_barrier(const XcdBarrier& b) {
    asm volatile("s_waitcnt vmcnt(0)" ::: "memory");
    __syncthreads();
    if (threadIdx.x == 0) {
        unsigned* bar = b.bar;
        __builtin_amdgcn_s_waitcnt(0);
        unsigned nloc = b.st[0], nx = b.st[1];
        if (nloc == 0u) { xcd_barrier_complete(bar, b.x, nloc, nx); b.st[0] = nloc; b.st[1] = nx; }
        const unsigned old = xb_add(&bar[XB_XSUB(b.x)], 1u);
        const unsigned gen = old / nloc;
        if (old + 1u == (gen + 1u) * nloc) {
            __builtin_amdgcn_fence(__ATOMIC_RELEASE, "agent");
            asm volatile("s_waitcnt vmcnt(0)" ::: "memory");
            const unsigned og = xb_add(&bar[XB_TOP], 1u);
            const unsigned tg = og / nx;
            if (og + 1u == (tg + 1u) * nx) xb_add(&bar[XB_TOPGEN], 1u);
            else XB_SPIN(xb_ld(&bar[XB_TOPGEN]) == tg, bar);
            __builtin_amdgcn_fence(__ATOMIC_ACQUIRE, "agent");
            xb_add(&bar[XB_XGEN(b.x)], 1u);
            asm volatile("s_waitcnt vmcnt(0)" ::: "memory");
        } else {
            XB_SPIN(xb_ld(&bar[XB_XGEN(b.x)]) == gen, bar);
            __builtin_amdgcn_fence(__ATOMIC_ACQUIRE, "agent");
            asm volatile("s_waitcnt vmcnt(0)" ::: "memory");
        }
    }
    __syncthreads();
}

typedef float f32x2 __attribute__((ext_vector_type(2)));
typedef unsigned u32x2 __attribute__((ext_vector_type(2)));
typedef int i32x4 __attribute__((ext_vector_type(4)));
typedef int i32x2 __attribute__((ext_vector_type(2)));
struct Frame {
    LAS unsigned char* lds;
    volatile LAS unsigned* MISC;
    gu32* ctl;
    int tid, lane, wave;
    int vcu, G;
    const float* const* in;
    unsigned char* ws; float* out;
};
__device__ __forceinline__ float bf_lo(unsigned u) { return __uint_as_float(u << 16); }
__device__ __forceinline__ float bf_hi(unsigned u) { return __uint_as_float(u & 0xffff0000u); }
__device__ __forceinline__ unsigned pkbf(float lo, float hi) { return pg8::cvt_pk_bf16(lo, hi); }
__device__ __forceinline__ float wave_sum(float v) {
#pragma unroll
    for (int o = 1; o < 64; o <<= 1) v += __shfl_xor(v, o);
    return v;
}
__device__ __forceinline__ float dot4(f32x4 a, f32x4 b) { return (a.x * b.x + a.y * b.y) + (a.z * b.z + a.w * b.w); }
__device__ __forceinline__ float silu_f(float x) { return x * pg8::fast_sigmoid(x); }

#define P0_LOAD(R, src, ldn) do { _Pragma("unroll") for (int j_ = 0; j_ < 16; ++j_) R[j_] = __builtin_nontemporal_load((const f32x4*)((src) + (size_t)(4 * j_ + (lane >> 4)) * (ldn) + 4 * (lane & 15))); } while (0)
__device__ __forceinline__ void p0_item_addr(int r, int li, const float* const* kargs, unsigned char* ws, const float*& src, int& ldn, bf16*& dst, int& ldk) {
#define in(k) ({ const float* const* p_ = kargs; asm volatile("" : "+s"(p_)); p_[k]; })
    constexpr int I_IN = 16 * 24, I_OUT = 16 * 16, I_GD = 16 * 44, I_DN = 44 * 16, I_PW1 = 16 * 16  , I_PW2 = 16 * 16, I_GX = 16 * 56  , I_DX = 56 * 16  , I_PL = 4  ;
    unsigned char* we = ws + WS_WE + (size_t)li * WE_STRIDE; unsigned char* wo = ws + WS_WO + (size_t)li * WO_STRIDE;
#define P0_PAIR(Wp, K_, N_, dstp, half, q) do { const int nb_ = (N_) / 64, kb_ = (q) / nb_, n0_ = ((q) % nb_) * 64; src = (Wp) + (size_t)(kb_ * 64) * (N_) + n0_; ldn = (N_); \
        dst = (dstp) + (size_t)((n0_ >> 7) * 256 + (half) * 128 + (n0_ & 127)) * (K_) + kb_ * 64; ldk = (K_); } while (0)
#define P0_PLAIN(Wp, K_, N_, dstp, q) do { const int nb_ = (N_) / 64, kb_ = (q) / nb_, n0_ = ((q) % nb_) * 64; src = (Wp) + (size_t)(kb_ * 64) * (N_) + n0_; ldn = (N_); dst = (dstp) + (size_t)n0_ * (K_) + kb_ * 64; ldk = (K_); } while (0)
    if (r < NEXP * I_GX) { const int e = r / I_GX; P0_PAIR(in(24) + ((size_t)li * NEXP + e) * D * FFX, D, FFX, (bf16*)(wo + WO_GUX) + (size_t)e * 2 * FFX * D, 0, r % I_GX); return; } r -= NEXP * I_GX;
    if (r < NEXP * I_GX) { const int e = r / I_GX; P0_PAIR(in(25) + ((size_t)li * NEXP + e) * D * FFX, D, FFX, (bf16*)(wo + WO_GUX) + (size_t)e * 2 * FFX * D, 1, r % I_GX); return; } r -= NEXP * I_GX;
    if (r < NEXP * I_DX) { const int e = r / I_DX; P0_PLAIN(in(26) + ((size_t)li * NEXP + e) * FFX * D, FFX, D, (bf16*)(wo + WO_DNX) + (size_t)e * D * FFX, r % I_DX); return; } r -= NEXP * I_DX;
    if (r < I_IN) { P0_PLAIN(in(2) + (size_t)li * D * INE, D, INE, (bf16*)(we + WE_IN), r); return; } r -= I_IN;
    if (r < I_OUT) { P0_PLAIN(in(8) + (size_t)li * D * D, D, D, (bf16*)(we + WE_OUT), r); return; } r -= I_OUT;
    if (r < I_GD) { P0_PAIR(in(10) + (size_t)li * D * FFD, D, FFD, (bf16*)(we + WE_GU), 0, r); return; } r -= I_GD;
    if (r < I_GD) { P0_PAIR(in(11) + (size_t)li * D * FFD, D, FFD, (bf16*)(we + WE_GU), 1, r); return; } r -= I_GD;
    if (r < I_DN) { P0_PLAIN(in(12) + (size_t)li * FFD * D, FFD, D, (bf16*)(we + WE_DN), r); return; } r -= I_DN;
    if (r < 2 * I_PW1) { const int half = r / I_PW1, q = r % I_PW1, kb = q / 16, n0 = (q % 16) * 64;
        src = in(14) + (size_t)li * D * 2 * D + (size_t)(kb * 64) * (2 * D) + half * D + n0; ldn = 2 * D; dst = (bf16*)(wo + WO_PW1) + (size_t)((n0 >> 7) * 256 + half * 128 + (n0 & 127)) * D + kb * 64; ldk = D; return; } r -= 2 * I_PW1;
    if (r < I_PW2) { P0_PLAIN(in(20) + (size_t)li * D * D, D, D, (bf16*)(wo + WO_PW2), r); return; } r -= I_PW2;
    { const int g = r / I_PL; P0_PLAIN(in(6) + ((size_t)li * NGRP + g) * GD * GD, GD, GD, (bf16*)(we + WE_PL) + (size_t)g * GD * GD, r % I_PL); }
#undef P0_PAIR
#undef P0_PLAIN
#undef in
}
__device__ __forceinline__ void p0_prologue(Frame& F, const float* const* kargs) {
#define in(k) ({ const float* const* p_ = kargs; asm volatile("" : "+s"(p_)); p_[k]; })
    int tid_l = F.tid; asm volatile("" : "+v"(tid_l)); const int tid = tid_l, lane = tid & 63, wave = __builtin_amdgcn_readfirstlane(tid >> 6); (void)tid; (void)lane; (void)wave;
    LAS float* scr = (LAS float*)(F.lds + RING_OFF + wave * 16640);
    const int gw = F.vcu * NWAVES + wave, NGW = F.G * NWAVES;
    constexpr int I_IN = 16 * 24, I_OUT = 16 * 16, I_GD = 16 * 44, I_DN = 44 * 16, I_PW1 = 16 * 16, I_PW2 = 16 * 16, I_GX = 16 * 56, I_DX = 56 * 16, I_PL = 4;
    constexpr int NIT = I_IN + I_OUT + 2 * I_GD + I_DN + 2 * I_PW1 + I_PW2 + NEXP * (2 * I_GX + I_DX) + NGRP * I_PL;
    int it = gw;
    const float* src = nullptr; int ldn = 0; bf16* dst = nullptr; int ldk = 0;
    f32x4 A[16], B[16];
    if (it < 2 * NIT) { p0_item_addr(it % NIT, it / NIT, kargs, F.ws, src, ldn, dst, ldk); P0_LOAD(A, src, ldn); }
    while (it < 2 * NIT) {
        const int itn = it + NGW; const bool hn = itn < 2 * NIT;
        const float* src1 = nullptr; int ldn1 = 0; bf16* dst1 = nullptr; int ldk1 = 0;
        if (hn) { p0_item_addr(itn % NIT, itn / NIT, kargs, F.ws, src1, ldn1, dst1, ldk1); P0_LOAD(B, src1, ldn1); }
#pragma unroll
        for (int j = 0; j < 16; ++j) { LAS float* p = scr + (4 * j + (lane >> 4)) * 65 + 4 * (lane & 15); p[0] = A[j].x; p[1] = A[j].y; p[2] = A[j].z; p[3] = A[j].w; }
        LDS_WAIT(); asm volatile("" ::: "memory");
        { const int c = lane & 7;
#pragma unroll
          for (int j = 0; j < 8; ++j) { const int n = (lane >> 3) + 8 * j; const LAS float* s = scr + (8 * c) * 65 + n;
              v4u o; o.x = pkbf(s[0 * 65], s[1 * 65]); o.y = pkbf(s[2 * 65], s[3 * 65]); o.z = pkbf(s[4 * 65], s[5 * 65]); o.w = pkbf(s[6 * 65], s[7 * 65]);
              *(GAS v4u*)(dst + (size_t)n * ldk + 8 * c) = o; } }
        LDS_WAIT(); asm volatile("" ::: "memory");
        if (hn) {
#pragma unroll
            for (int j = 0; j < 16; ++j) A[j] = B[j];
            dst = dst1; ldk = ldk1; }
        it = itn;
    }
    for (int li = 0; li < 2; ++li) { const float* wsp = in(4) + (size_t)li * NHEAD * CHUNK * CHUNK; bf16* dsp = (bf16*)(F.ws + WS_WE + (size_t)li * WE_STRIDE + WE_SP);
        for (int q = (F.vcu * NWAVES * 64 + tid); q < NHEAD * CHUNK * CHUNK / 4; q += F.G * NWAVES * 64) {
            const int e0 = q * 4, t = (e0 >> 7) & 127, s = e0 & 127; const f32x4 v = *(const f32x4*)(wsp + e0);
            u32x2 o; o.x = pkbf(s + 0 <= t ? v.x : 0.f, s + 1 <= t ? v.y : 0.f); o.y = pkbf(s + 2 <= t ? v.z : 0.f, s + 3 <= t ? v.w : 0.f);
            *(GAS u32x2*)(dsp + e0) = o; } }
#undef in
}
__device__ __forceinline__ void rms_phase(Frame& F, const float* src, const float* gain, bf16* dst) {
    int tid_l = F.tid; asm volatile("" : "+v"(tid_l)); const int tid = tid_l, lane = tid & 63, wave = __builtin_amdgcn_readfirstlane(tid >> 6); (void)tid; (void)lane; (void)wave;
    const int gw = F.vcu * NWAVES + wave, NGW = F.G * NWAVES;
    f32x4 g[4];
#pragma unroll
    for (int j = 0; j < 4; ++j) g[j] = *(const f32x4*)(gain + 4 * lane + 256 * j);
    for (int m = gw; m < M; m += NGW) {
        const GAS f32x4* xr = (const GAS f32x4*)(src + (size_t)m * D) + lane;
        f32x4 v[4]; float s = 0.f;
#pragma unroll
        for (int j = 0; j < 4; ++j) { v[j] = xr[64 * j]; s += dot4(v[j], v[j]); }
        const float rstd = 1.0f / sqrtf(wave_sum(s) * (1.f / D) + EPS);
        GAS u32x2* o8 = (GAS u32x2*)(dst + (size_t)m * D) + lane;
#pragma unroll
        for (int j = 0; j < 4; ++j) { const f32x4 y = v[j] * rstd * g[j]; u32x2 w; w.x = pkbf(y.x, y.y); w.y = pkbf(y.z, y.w); o8[64 * j] = w; }
    }
}
constexpr int TSTR = 272;
__device__ __forceinline__ void mixer_phase(Frame& F, int li, const float* sgu_norm, const float* b_spatial, const float* pool_scale) {
    const bf16* proj = (const bf16*)(F.ws + WS_PROJ); bf16* mix = (bf16*)(F.ws + WS_MIX);
    const bf16* wsp = (const bf16*)(F.ws + WS_WE + (size_t)li * WE_STRIDE + WE_SP); const bf16* wpl = (const bf16*)(F.ws + WS_WE + (size_t)li * WE_STRIDE + WE_PL);
    int tid_l = F.tid; asm volatile("" : "+v"(tid_l)); const int tid = tid_l, lane = tid & 63, wave = __builtin_amdgcn_readfirstlane(tid >> 6); (void)tid; (void)lane; (void)wave;
    const int fr = lane & 15, fq = lane >> 4;
    LAS float* rs = (LAS float*)(F.lds + RING_OFF);
    LAS unsigned char* T = F.lds + RING_OFF + 512 + wave * (64 * TSTR);
    for (int u = F.vcu; u < 2 * (M / CHUNK); u += F.G) {
        const int chunk = u >> 1, part = u & 1, tok0 = chunk * CHUNK;
        if (part == 0) {
            const bf16* vbase = proj + (size_t)tok0 * INE + AW;
#pragma unroll 4
            for (int r = 0; r < 16; ++r) { const int row = wave * 16 + r; const v4u q = *(const GAS v4u*)(vbase + (size_t)row * INE + lane * 8);
                float s = 0.f;
#pragma unroll
                for (int k = 0; k < 4; ++k) { const float a = bf_lo(q[k]), b = bf_hi(q[k]); s += a * a + b * b; }
                s = wave_sum(s); if (lane == 0) rs[row] = 1.0f / sqrtf(s * (1.f / AW) + EPS); }
            __syncthreads();
            const int h = wave, rp = lane >> 3, cg = lane & 7;
            { const f32x4 ga = *(const f32x4*)(sgu_norm + li * AW + h * HD + cg * 8), gb = *(const f32x4*)(sgu_norm + li * AW + h * HD + cg * 8 + 4);
              const float gv[8] = {ga.x, ga.y, ga.z, ga.w, gb.x, gb.y, gb.z, gb.w};
#pragma unroll
              for (int st = 0; st < 8; ++st) { const int s = st * 16 + 2 * rp;
                  const v4u q0 = *(const GAS v4u*)(vbase + (size_t)s * INE + h * HD + cg * 8), q1 = *(const GAS v4u*)(vbase + (size_t)(s + 1) * INE + h * HD + cg * 8);
                  const float r0 = rs[s], r1 = rs[s + 1];
#pragma unroll
                  for (int k = 0; k < 4; ++k) {
                      *(LAS unsigned*)(T + (cg * 8 + 2 * k) * TSTR + s * 2) = pkbf(bf_lo(q0[k]) * r0 * gv[2 * k], bf_lo(q1[k]) * r1 * gv[2 * k]);
                      *(LAS unsigned*)(T + (cg * 8 + 2 * k + 1) * TSTR + s * 2) = pkbf(bf_hi(q0[k]) * r0 * gv[2 * k + 1], bf_hi(q1[k]) * r1 * gv[2 * k + 1]); } } }
            LDS_WAIT(); asm volatile("" ::: "memory");
            const bf16* Wh = wsp + (size_t)h * CHUNK * CHUNK; const float* bs = b_spatial + (li * NHEAD + h) * CHUNK;
#pragma unroll
            for (int ti = 0; ti < 8; ++ti) {
                constexpr int dummy = 0; (void)dummy;
                const int nks = ti / 2 + 1;
                bf16x8 bw[4];
#pragma unroll
                for (int ks = 0; ks < 4; ++ks) if (ks < nks) bw[ks] = *(const GAS bf16x8*)(Wh + (size_t)(16 * ti + fr) * CHUNK + 32 * ks + 8 * fq);
                const int t = 16 * ti + fr; const float bt = bs[t]; const size_t tok = (size_t)tok0 + t;
#pragma unroll
                for (int dj = 0; dj < 4; ++dj) {
                    f32x4 acc = (f32x4){0.f, 0.f, 0.f, 0.f};
#pragma unroll
                    for (int ks = 0; ks < 4; ++ks) if (ks < nks) { const bf16x8 a = *(const LAS bf16x8*)(T + (16 * dj + fr) * TSTR + (32 * ks + 8 * fq) * 2); acc = __builtin_amdgcn_mfma_f32_16x16x32_bf16(a, bw[ks], acc, 0, 0, 0); }
                    const int d = 16 * dj + 4 * fq;
                    const u32x2 uu = *(const GAS u32x2*)(proj + tok * INE + h * HD + d);
                    u32x2 o; o.x = pkbf(bf_lo(uu.x) * (acc[0] + bt), bf_hi(uu.x) * (acc[1] + bt)); o.y = pkbf(bf_lo(uu.y) * (acc[2] + bt), bf_hi(uu.y) * (acc[3] + bt));
                    *(GAS u32x2*)(mix + tok * D + h * HD + d) = o;
                }
            }
        } else {
            const int g = wave >> 1, rh = wave & 1, win = 2 << g;
            const int p0 = (tok0 & (SEQ - 1)) + 64 * rh;
            const size_t tokr = (size_t)tok0 + 64 * rh;
            const bf16* zb = proj + 2 * AW + g * GD + 2 * lane;
            float sx = 0.f, sy = 0.f;
#pragma unroll
            for (int j = 1; j <= 16; ++j) { const bool valid = (j <= win) && (p0 - j >= 0); const size_t row = valid ? tokr - j : tokr;
                const unsigned q = *(const GAS unsigned*)(zb + row * INE); sx += valid ? bf_lo(q) : 0.f; sy += valid ? bf_hi(q) : 0.f; }
#pragma unroll 8
            for (int i = 0; i < 64; ++i) { const bool valid = (p0 + i - win >= 0); const size_t rowo = valid ? tokr + i - win : tokr;
                const unsigned q = *(const GAS unsigned*)(zb + (tokr + i) * INE), qo = *(const GAS unsigned*)(zb + rowo * INE);
                const float zx = bf_lo(q), zy = bf_hi(q);
                sx += zx - (valid ? bf_lo(qo) : 0.f); sy += zy - (valid ? bf_hi(qo) : 0.f);
                const int cnt = (p0 + i + 1 < win) ? (p0 + i + 1) : win; const float inv = 1.0f / (float)cnt;
                *(LAS unsigned*)(T + i * TSTR + lane * 4) = pkbf(sx * inv - zx, sy * inv - zy); }
            LDS_WAIT(); asm volatile("" ::: "memory");
            const bf16* Wp = wpl + (size_t)g * GD * GD;
            bf16x8 bm[4][4];
#pragma unroll
            for (int ti = 0; ti < 4; ++ti)
#pragma unroll
                for (int ks = 0; ks < 4; ++ks) bm[ti][ks] = *(const LAS bf16x8*)(T + (16 * ti + fr) * TSTR + (32 * ks + 8 * fq) * 2);
#pragma unroll 2
            for (int dj = 0; dj < 8; ++dj) {
                bf16x8 aw[4];
#pragma unroll
                for (int ks = 0; ks < 4; ++ks) aw[ks] = *(const GAS bf16x8*)(Wp + (size_t)(16 * dj + fr) * GD + 32 * ks + 8 * fq);
                const f32x4 sc = *(const f32x4*)(pool_scale + li * BW + g * GD + 16 * dj + 4 * fq);
#pragma unroll
                for (int ti = 0; ti < 4; ++ti) {
                    f32x4 acc = (f32x4){0.f, 0.f, 0.f, 0.f};
#pragma unroll
                    for (int ks = 0; ks < 4; ++ks) acc = __builtin_amdgcn_mfma_f32_16x16x32_bf16(aw[ks], bm[ti][ks], acc, 0, 0, 0);
                    u32x2 o; o.x = pkbf(acc[0] * sc.x, acc[1] * sc.y); o.y = pkbf(acc[2] * sc.z, acc[3] * sc.w);
                    *(GAS u32x2*)(mix + (tokr + 16 * ti + fr) * D + AW + g * GD + 16 * dj + 4 * fq) = o;
                }
            }
        }
        __syncthreads();
    }
}
__device__ __forceinline__ void conv_phase(Frame& F, const float* w_dw, const float* b_dw, const float* ln_g, const float* ln_b) {
    const bf16* glu = (const bf16*)(F.ws + WS_GLU); bf16* cvo = (bf16*)(F.ws + WS_CV);
    int tid_l = F.tid; asm volatile("" : "+v"(tid_l)); const int tid = tid_l, lane = tid & 63, wave = __builtin_amdgcn_readfirstlane(tid >> 6); (void)tid; (void)lane; (void)wave;
    const int c0 = 2 * tid;
    LAS float* cv = (LAS float*)(F.lds + RING_OFF);
    f32x2 w[CONVK];
#pragma unroll
    for (int k = 0; k < CONVK; ++k) w[k] = *(const f32x2*)(w_dw + (size_t)k * D + c0);
    const f32x2 bd = *(const f32x2*)(b_dw + c0);
    for (int u = F.vcu; u < M / 16; u += F.G) {
        const int tok0 = u * 16; const bool hist = (tok0 & (SEQ - 1)) != 0;
        unsigned xin[46];
#pragma unroll
        for (int j = 0; j < 46; ++j) { const bool valid = (j >= 30) || hist; const size_t row = valid ? (size_t)(tok0 - 30 + j) : (size_t)tok0;
            const unsigned q = *(const GAS unsigned*)(glu + row * D + c0); xin[j] = valid ? q : 0u; }
        f32x2 acc[16];
#pragma unroll
        for (int i = 0; i < 16; ++i) acc[i] = bd;
#pragma unroll
        for (int j = 0; j < 46; ++j) { const f32x2 x = (f32x2){bf_lo(xin[j]), bf_hi(xin[j])};
#pragma unroll
            for (int i = 0; i < 16; ++i) if (j - i >= 0 && j - i <= 30) acc[i] += w[j - i] * x; }
#pragma unroll
        for (int i = 0; i < 16; ++i) *(LAS f32x2*)(cv + i * D + c0) = acc[i];
        __syncthreads();
#pragma unroll
        for (int rr = 0; rr < 2; ++rr) { const int row = 2 * wave + rr;
            f32x4 v[4]; float s = 0.f;
#pragma unroll
            for (int j = 0; j < 4; ++j) { v[j] = *(const LAS f32x4*)(cv + row * D + 4 * lane + 256 * j); s += (v[j].x + v[j].y) + (v[j].z + v[j].w); }
            const float mean = wave_sum(s) * (1.f / D); float s2 = 0.f;
#pragma unroll
            for (int j = 0; j < 4; ++j) { v[j] = v[j] - mean; s2 += dot4(v[j], v[j]); }
            const float rstd = 1.0f / sqrtf(wave_sum(s2) * (1.f / D) + EPS);
            GAS u32x2* o8 = (GAS u32x2*)(cvo + (size_t)(tok0 + row) * D) + lane;
#pragma unroll
            for (int j = 0; j < 4; ++j) { const f32x4 gg = *(const f32x4*)(ln_g + 4 * lane + 256 * j), bb = *(const f32x4*)(ln_b + 4 * lane + 256 * j);
                const f32x4 y = v[j] * rstd * gg + bb; u32x2 o; o.x = pkbf(silu_f(y.x), silu_f(y.y)); o.y = pkbf(silu_f(y.z), silu_f(y.w)); o8[64 * j] = o; } }
        __syncthreads();
    }
}
__device__ __forceinline__ void router_phase(Frame& F, const float* src, const float* gain, const float* w_router, bf16* dst, gu32* cnt) {
    int tid_l = F.tid; asm volatile("" : "+v"(tid_l)); const int tid = tid_l, lane = tid & 63, wave = __builtin_amdgcn_readfirstlane(tid >> 6); (void)tid; (void)lane; (void)wave;
    const int gw = F.vcu * NWAVES + wave, NGW = F.G * NWAVES;
    LAS float* wrT = (LAS float*)(F.lds + RING_OFF);
    LAS unsigned* lc = (LAS unsigned*)(F.lds + RING_OFF + 32768);
    for (int c = tid; c < D; c += NWAVES * 64) { const f32x4 a = *(const f32x4*)(w_router + (size_t)c * NEXP), b = *(const f32x4*)(w_router + (size_t)c * NEXP + 4);
        wrT[0 * D + c] = a.x; wrT[1 * D + c] = a.y; wrT[2 * D + c] = a.z; wrT[3 * D + c] = a.w; wrT[4 * D + c] = b.x; wrT[5 * D + c] = b.y; wrT[6 * D + c] = b.z; wrT[7 * D + c] = b.w; }
    if (tid < NEXP) lc[tid] = 0u;
    __syncthreads();
    f32x4 g[4];
#pragma unroll
    for (int j = 0; j < 4; ++j) g[j] = *(const f32x4*)(gain + 4 * lane + 256 * j);
    i32x4* tokinfo = (i32x4*)(F.ws + WS_TOKINFO);
    for (int m = gw; m < M; m += NGW) {
        const GAS f32x4* xr = (const GAS f32x4*)(src + (size_t)m * D) + lane;
        f32x4 v[4]; float s = 0.f;
#pragma unroll
        for (int j = 0; j < 4; ++j) { v[j] = xr[64 * j]; s += dot4(v[j], v[j]); }
        const float rstd = 1.0f / sqrtf(wave_sum(s) * (1.f / D) + EPS);
        GAS u32x2* o8 = (GAS u32x2*)(dst + (size_t)m * D) + lane;
#pragma unroll
        for (int j = 0; j < 4; ++j) { v[j] = v[j] * rstd * g[j]; u32x2 w; w.x = pkbf(v[j].x, v[j].y); w.y = pkbf(v[j].z, v[j].w); o8[64 * j] = w; }
        float lg[NEXP];
#pragma unroll
        for (int e = 0; e < NEXP; ++e) { float p = 0.f;
#pragma unroll
            for (int j = 0; j < 4; ++j) p += dot4(v[j], *(const LAS f32x4*)(wrT + e * D + 4 * lane + 256 * j));
            lg[e] = wave_sum(p); }
        int i1 = 0; float l1 = lg[0];
#pragma unroll
        for (int e = 1; e < NEXP; ++e) if (lg[e] > l1) { l1 = lg[e]; i1 = e; }
        int i2 = -1; float l2 = -INFINITY;
#pragma unroll
        for (int e = 0; e < NEXP; ++e) if (e != i1 && lg[e] > l2) { l2 = lg[e]; i2 = e; }
        const float g1 = 1.0f / (1.0f + __expf(l2 - l1)), g2 = 1.0f - g1;
        if (lane == 0) { tokinfo[m] = (i32x4){i1, i2, (int)__float_as_uint(g1), (int)__float_as_uint(g2)}; __hip_atomic_fetch_add(&lc[i1], 1u, __ATOMIC_RELAXED, __HIP_MEMORY_SCOPE_WORKGROUP); __hip_atomic_fetch_add(&lc[i2], 1u, __ATOMIC_RELAXED, __HIP_MEMORY_SCOPE_WORKGROUP); }
    }
    __syncthreads();
    if (tid < NEXP) __hip_atomic_fetch_add(cnt + 64 * tid, (unsigned)lc[tid], RLX_AGENT);
}
__device__ __forceinline__ void scatter_phase(Frame& F, gu32* cnt, gu32* cursor) {
    const bf16* hn = (const bf16*)(F.ws + WS_HN); bf16* hp = (bf16*)(F.ws + WS_HP);
    const i32x4* tokinfo = (const i32x4*)(F.ws + WS_TOKINFO); i32x2* tokslot = (i32x2*)(F.ws + WS_TOKSLOT); float* slotgate = (float*)(F.ws + WS_SLOTGATE);
    LAS int* pbase = (LAS int*)(F.lds + RING_OFF);
    LAS int* lcnt = pbase + 8;
    LAS int* base = pbase + 16;
    LAS int* sl = pbase + 32;
    int tid_l = F.tid; asm volatile("" : "+v"(tid_l)); const int tid = tid_l, lane = tid & 63, wave = __builtin_amdgcn_readfirstlane(tid >> 6); (void)tid; (void)lane; (void)wave;
    if (tid == 0) { int acc = 0;
#pragma unroll
        for (int e = 0; e < NEXP; ++e) { pbase[e] = acc * 256; acc += ((int)__hip_atomic_load(cnt + 64 * e, RLX_AGENT) + 255) >> 8; } }
    for (int u = F.vcu; u < M / 64; u += F.G) {
        const int tok0 = u * 64;
        if (tid < NEXP) lcnt[tid] = 0;
        __syncthreads();
        i32x4 info = (i32x4){0, 0, 0, 0}; int r1 = 0, r2 = 0;
        if (tid < 64) { info = tokinfo[tok0 + tid]; r1 = __hip_atomic_fetch_add(&lcnt[info.x], 1, __ATOMIC_RELAXED, __HIP_MEMORY_SCOPE_WORKGROUP); r2 = __hip_atomic_fetch_add(&lcnt[info.y], 1, __ATOMIC_RELAXED, __HIP_MEMORY_SCOPE_WORKGROUP); }
        __syncthreads();
        if (tid < NEXP) base[tid] = pbase[tid] + (int)__hip_atomic_fetch_add(cursor + 64 * tid, (unsigned)lcnt[tid], RLX_AGENT);
        __syncthreads();
        if (tid < 64) { const int s1 = base[info.x] + r1, s2 = base[info.y] + r2;
            tokslot[tok0 + tid] = (i32x2){s1, s2}; slotgate[s1] = __uint_as_float((unsigned)info.z); slotgate[s2] = __uint_as_float((unsigned)info.w);
            sl[2 * tid] = s1; sl[2 * tid + 1] = s2; }
        __syncthreads();
#pragma unroll 4
        for (int q = 0; q < 8; ++q) { const int tl = wave * 8 + q; const int s1 = sl[2 * tl], s2 = sl[2 * tl + 1];
            const GAS v4u* src = (const GAS v4u*)(hn + (size_t)(tok0 + tl) * D) + lane; const v4u a = src[0], b = src[64];
            GAS v4u* d1 = (GAS v4u*)(hp + (size_t)s1 * D) + lane; GAS v4u* d2 = (GAS v4u*)(hp + (size_t)s2 * D) + lane;
            d1[0] = a; d1[64] = b; d2[0] = a; d2[64] = b; }
        __syncthreads();
    }
}
__device__ __forceinline__ void combine_phase(Frame& F, float* h, const float* gain, bf16* dst, float* fout) {
    int tid_l = F.tid; asm volatile("" : "+v"(tid_l)); const int tid = tid_l, lane = tid & 63, wave = __builtin_amdgcn_readfirstlane(tid >> 6); (void)tid; (void)lane; (void)wave;
    const int gw = F.vcu * NWAVES + wave, NGW = F.G * NWAVES;
    const bf16* y = (const bf16*)(F.ws + WS_Y); const i32x2* tokslot = (const i32x2*)(F.ws + WS_TOKSLOT);
    f32x4 g[4];
#pragma unroll
    for (int j = 0; j < 4; ++j) g[j] = *(const f32x4*)(gain + 4 * lane + 256 * j);
    for (int m = gw; m < M; m += NGW) {
        const i32x2 ss = tokslot[m];
        GAS f32x4* xr = (GAS f32x4*)(h + (size_t)m * D) + lane;
        const GAS u32x2* y1 = (const GAS u32x2*)(y + (size_t)ss.x * D) + lane; const GAS u32x2* y2 = (const GAS u32x2*)(y + (size_t)ss.y * D) + lane;
        f32x4 v[4]; float s = 0.f;
#pragma unroll
        for (int j = 0; j < 4; ++j) { const u32x2 a = y1[64 * j], b = y2[64 * j]; v[j] = xr[64 * j];
            v[j].x += bf_lo(a.x) + bf_lo(b.x); v[j].y += bf_hi(a.x) + bf_hi(b.x); v[j].z += bf_lo(a.y) + bf_lo(b.y); v[j].w += bf_hi(a.y) + bf_hi(b.y);
            s += dot4(v[j], v[j]); }
        const float rstd = 1.0f / sqrtf(wave_sum(s) * (1.f / D) + EPS);
        if (fout) { GAS f32x4* o = (GAS f32x4*)(fout + (size_t)m * D) + lane;
#pragma unroll
            for (int j = 0; j < 4; ++j) o[64 * j] = v[j] * rstd * g[j]; }
        else { GAS u32x2* o8 = (GAS u32x2*)(dst + (size_t)m * D) + lane;
#pragma unroll
            for (int j = 0; j < 4; ++j) { xr[64 * j] = v[j]; const f32x4 yv = v[j] * rstd * g[j]; u32x2 w; w.x = pkbf(yv.x, yv.y); w.y = pkbf(yv.z, yv.w); o8[64 * j] = w; } }
    }
}

struct Args { const float* in[28]; float* out; unsigned char* ws; int ph_lo, ph_hi; };
#define PG8_ALIGN true
#define PG8_SP2 true
__global__ void __launch_bounds__(NWAVES * 64, 2) trunk_fwd(Args args) {
    extern __shared__ __attribute__((aligned(16))) unsigned char lds[];
    Frame F;
    F.lds = (LAS unsigned char*)lds;
    F.MISC = (volatile LAS unsigned*)(F.lds + MISC_OFF);
    F.tid = threadIdx.x; F.lane = F.tid & 63; F.wave = __builtin_amdgcn_readfirstlane(F.tid >> 6);
    F.G = gridDim.x; { const int bx = blockIdx.x; F.vcu = (F.G % 8 == 0) ? (bx % 8) * (F.G / 8) + bx / 8 : bx; }
    F.ws = args.ws; F.out = args.out; F.in = nullptr;
    F.ctl = (gu32*)(args.ws + WS_CTL);
    for (int u = F.tid; u < (LDS_BYTES - LDSCTL_OFF) / 4; u += NWAVES * 64) ((LAS unsigned*)(F.lds + LDSCTL_OFF))[u] = 0u;
    __syncthreads();
    XcdBarrier bar = xcd_barrier_post((unsigned*)(F.ctl + CW_BAR), F.MISC + 8);
    const float* const* kargs = (const float* const*)__builtin_amdgcn_kernarg_segment_ptr();
#define INP(k) ({ const float* const* p_ = kargs; asm volatile("" : "+s"(p_)); p_[k]; })
    const int lo = args.ph_lo, hi = args.ph_hi;
    int ph = 0;
#ifndef PHMASK
#define PHMASK 0xffff
#endif
#define EN(k) (((PHMASK) >> (k)) & 1)
#define RUN() (lo <= ph && ph < hi)
#define SEAM() do { if (lo <= ph && ph + 1 < hi) { xcd_barrier(bar); if (PROBE_DUP & 16) { xcd_barrier(bar); xcd_barrier(bar); } } ++ph; } while (0)
    unsigned char* const ws = args.ws;
    float* const H = (float*)(ws + WS_H); bf16* const HN = (bf16*)(ws + WS_HN);

#ifndef PROBE_DUP
#define PROBE_DUP 0
#endif
    if (EN(0) && RUN()) { p0_prologue(F, kargs); if (PROBE_DUP & 1) p0_prologue(F, kargs); rms_phase(F, INP(0), INP(1), HN); }
    SEAM();

#pragma unroll 1
    for (int li = 0; li < 2; ++li) {
        unsigned char* const we = ws + WS_WE + (size_t)li * WE_STRIDE; unsigned char* const wo = ws + WS_WO + (size_t)li * WO_STRIDE;
        if (EN(1) && RUN()) { pg8::Gemm g{HN, (const bf16*)(we + WE_IN), M, INE, D}; pg8::StaticOrder S; S.init(M, INE, F.G, (int)blockIdx.x);
            pg8::EpiGeluSplit E{(bf16*)(ws + WS_PROJ), INE, 4};
            pg8::gemm_phase<pg8::EpiGeluSplit, pg8::StaticOrder, PG8_ALIGN, PG8_SP2>(F.lds + RING_OFF, g, S, E); }
        SEAM();
        if (EN(2) && RUN()) { mixer_phase(F, li, INP(3), INP(5), INP(7)); if (PROBE_DUP & 2) mixer_phase(F, li, INP(3), INP(5), INP(7)); }
        SEAM();
        if (EN(3) && RUN()) { pg8::Gemm g{(const bf16*)(ws + WS_MIX), (const bf16*)(we + WE_OUT), M, D, D}; pg8::StaticOrder S; S.init(M, D, F.G, (int)blockIdx.x);
            pg8::EpiRes E{li == 0 ? INP(0) : (const float*)H, H, D, nullptr};
            pg8::gemm_phase<pg8::EpiRes, pg8::StaticOrder, PG8_ALIGN, PG8_SP2>(F.lds + RING_OFF, g, S, E); }
        SEAM();
        if (EN(4) && RUN()) { rms_phase(F, H, INP(9) + li * D, HN); if (PROBE_DUP & 4) rms_phase(F, H, INP(9) + li * D, HN); }
        SEAM();
        if (EN(5) && RUN()) { pg8::Gemm g{HN, (const bf16*)(we + WE_GU), M, 2 * FFD, D}; pg8::StaticOrder S; S.init(M, 2 * FFD, F.G, (int)blockIdx.x);
            pg8::EpiGlu<0> E{(bf16*)(ws + WS_ACT), FFD, nullptr, nullptr};
            pg8::gemm_phase<pg8::EpiGlu<0>, pg8::StaticOrder, PG8_ALIGN, PG8_SP2>(F.lds + RING_OFF, g, S, E); }
        SEAM();
        if (EN(6) && RUN()) { pg8::Gemm g{(const bf16*)(ws + WS_ACT), (const bf16*)(we + WE_DN), M, D, FFD}; pg8::StaticOrder S; S.init(M, D, F.G, (int)blockIdx.x);
            pg8::EpiRes E{H, H, D, nullptr};
            pg8::gemm_phase<pg8::EpiRes, pg8::StaticOrder, PG8_ALIGN, PG8_SP2>(F.lds + RING_OFF, g, S, E); }
        SEAM();
        if (EN(7) && RUN()) rms_phase(F, H, INP(13) + li * D, HN);
        SEAM();
        if (EN(8) && RUN()) { pg8::Gemm g{HN, (const bf16*)(wo + WO_PW1), M, 2 * D, D}; pg8::StaticOrder S; S.init(M, 2 * D, F.G, (int)blockIdx.x);
            pg8::EpiGlu<1> E{(bf16*)(ws + WS_GLU), D, INP(15) + li * 2 * D, INP(15) + li * 2 * D + D};
            pg8::gemm_phase<pg8::EpiGlu<1>, pg8::StaticOrder, PG8_ALIGN, PG8_SP2>(F.lds + RING_OFF, g, S, E); }
        SEAM();
        if (EN(9) && RUN() && (PROBE_DUP & 8)) conv_phase(F, INP(16) + (size_t)li * CONVK * D, INP(17) + li * D, INP(18) + li * D, INP(19) + li * D);
        if (EN(9) && RUN()) conv_phase(F, INP(16) + (size_t)li * CONVK * D, INP(17) + li * D, INP(18) + li * D, INP(19) + li * D);
        SEAM();
        if (EN(10) && RUN()) { pg8::Gemm g{(const bf16*)(ws + WS_CV), (const bf16*)(wo + WO_PW2), M, D, D}; pg8::StaticOrder S; S.init(M, D, F.G, (int)blockIdx.x);
            pg8::EpiRes E{H, H, D, INP(21) + li * D};
            pg8::gemm_phase<pg8::EpiRes, pg8::StaticOrder, PG8_ALIGN, PG8_SP2>(F.lds + RING_OFF, g, S, E); }
        SEAM();
        gu32* const cnt = F.ctl + CW_MOE + li * 1024; gu32* const cursor = cnt + 512;
        if (EN(11) && RUN()) router_phase(F, H, INP(22) + li * D, INP(23) + (size_t)li * D * NEXP, HN, cnt);
        SEAM();
        if (EN(12) && RUN()) scatter_phase(F, cnt, cursor);
        SEAM();
        if (EN(13) && RUN()) { pg8::GroupedOrder S; { int acc = 0; S.ts[0] = 0;
#pragma unroll
                for (int e = 0; e < NEXP; ++e) { const int c = __builtin_amdgcn_readfirstlane((int)__hip_atomic_load(cnt + 64 * e, RLX_AGENT)); acc += (c + 255) >> 8; S.ts[e + 1] = acc; }
                S.nM = acc; S.nN = 2 * FFX / 256; S.nwg = acc * S.nN; S.G = F.G; S.c = (int)blockIdx.x; }
            pg8::Gemm g{(const bf16*)(ws + WS_HP), (const bf16*)(wo + WO_GUX), MSLOT, 2 * FFX, D};
            pg8::EpiGlu<0> E{(bf16*)(ws + WS_ACTX), FFX, nullptr, nullptr};
            pg8::gemm_phase<pg8::EpiGlu<0>, pg8::GroupedOrder, PG8_ALIGN, PG8_SP2>(F.lds + RING_OFF, g, S, E); }
        SEAM();
        if (EN(14) && RUN()) { pg8::GroupedOrder S; { int acc = 0; S.ts[0] = 0;
#pragma unroll
                for (int e = 0; e < NEXP; ++e) { const int c = __builtin_amdgcn_readfirstlane((int)__hip_atomic_load(cnt + 64 * e, RLX_AGENT)); acc += (c + 255) >> 8; S.ts[e + 1] = acc; }
                S.nM = acc; S.nN = D / 256; S.nwg = acc * S.nN; S.G = F.G; S.c = (int)blockIdx.x; }
            pg8::Gemm g{(const bf16*)(ws + WS_ACTX), (const bf16*)(wo + WO_DNX), MSLOT, D, FFX};
            pg8::EpiScale E{(bf16*)(ws + WS_Y), D, (const float*)(ws + WS_SLOTGATE)};
            pg8::gemm_phase<pg8::EpiScale, pg8::GroupedOrder, PG8_ALIGN, PG8_SP2>(F.lds + RING_OFF, g, S, E); }
        SEAM();
        if (EN(15) && RUN()) combine_phase(F, H, li == 0 ? INP(1) + D : INP(27), HN, li == 0 ? nullptr : args.out);
        SEAM();
    }
#undef RUN
#undef SEAM
}

extern "C" void kernel_launch(void* const* d_in, const int* in_sizes, int n_in, void* d_out, int out_size, void* d_ws, size_t ws_size, hipStream_t stream) {
    static int grid = 0;
    if (grid == 0) {
        if (n_in != 28 || in_sizes[0] != M * D || out_size != M * D || ws_size < WS_END) { fprintf(stderr, "kernel_launch: shape/workspace mismatch (n_in %d, in0 %d, out %d, ws %zu, need %zu); nothing launched\n", n_in, n_in > 0 ? in_sizes[0] : -1, out_size, ws_size, (size_t)WS_END); grid = -1; return; }
        int dev = 0, cus = 0, per_cu = 0;
        if (hipGetDevice(&dev) != hipSuccess || hipDeviceGetAttribute(&cus, hipDeviceAttributeMultiprocessorCount, dev) != hipSuccess) { grid = -1; return; }
        if (hipFuncSetAttribute((const void*)trunk_fwd, hipFuncAttributeMaxDynamicSharedMemorySize, LDS_BYTES) != hipSuccess) { fprintf(stderr, "kernel_launch: hipFuncSetAttribute failed\n"); grid = -1; return; }
        if (hipOccupancyMaxActiveBlocksPerMultiprocessor(&per_cu, (const void*)trunk_fwd, NWAVES * 64, LDS_BYTES) != hipSuccess || per_cu < 1)
            fprintf(stderr, "kernel_launch: note: occupancy query reports %d workgroups per CU\n", per_cu);
        (void)hipGetLastError();
        grid = cus;
    }
    if (grid < 0) return;
    if (hipMemsetAsync((char*)d_ws + WS_CTL, 0, CTL_ZERO_BYTES, stream) != hipSuccess) { fprintf(stderr, "kernel_launch: hipMemsetAsync failed\n"); return; }
    Args a{};
    for (int i = 0; i < 28; ++i) a.in[i] = (const float*)d_in[i];
    a.out = (float*)d_out; a.ws = (unsigned char*)d_ws;
#if MK_PER_PHASE
    for (int p = 0; p < NPH; ++p) { a.ph_lo = p; a.ph_hi = p + 1; hipLaunchKernelGGL(trunk_fwd, dim3(grid), dim3(NWAVES * 64), LDS_BYTES, stream, a); }
#else
    a.ph_lo = 0; a.ph_hi = NPH;
    hipLaunchKernelGGL(trunk_fwd, dim3(grid), dim3(NWAVES * 64), LDS_BYTES, stream, a);
#endif
    const hipError_t le = hipPeekAtLastError();
    if (le != hipSuccess) fprintf(stderr, "kernel_launch: launch failed: %s\n", hipGetErrorName(le));
}
```

```cpp
#include <hip/hip_runtime.h>
#include <cstdio>
#include <cstdint>
#include <cmath>
#ifndef MK_PER_PHASE
#define MK_PER_PHASE 0
#endif
namespace pg8 {
#define PG8_LAS __attribute__((address_space(3)))
typedef unsigned short bf16_t;
typedef short bf16x8 __attribute__((ext_vector_type(8)));
typedef float f32x4 __attribute__((ext_vector_type(4)));
typedef unsigned u32x4 __attribute__((ext_vector_type(4)));
constexpr int BM = 256, BK = 64, HALF = 128, HTB = HALF * BK * 2  , STAGE_BYTES = 8 * HTB, NXCD = 8, WGM = 8;

__host__ __device__ __forceinline__ int lds_byte(int r, int c) { const int st = (r >> 4) * 2 + (c >> 5), rr = r & 15, cc = c & 31, ob = rr * 64 + cc * 2; return st * 1024 + (ob ^ (((ob >> 9) & 1) << 5)); }
__host__ __device__ __forceinline__ void stage_rc(int b, int& R, int& C) { const int st = b / 1024, sb = b % 1024, swz = sb ^ (((sb >> 9) & 1) << 5); R = (st >> 1) * 16 + swz / 64; C = (st & 1) * 32 + (swz % 64) / 2; }
__host__ __device__ __forceinline__ int perm32(int rho) { const int n = rho >> 4, i = rho & 15; return 8 * (i >> 2) + 4 * n + (i & 3); }

struct Unit { int pm, pn, pb, koff; };
struct Gemm { const bf16_t* A; const bf16_t* Bt; int M, N, K, ld; };

struct StaticOrder {
    int nM, nN, nwg, G, c;
    __host__ __device__ void init(int M, int N, int G_, int c_) { nM = M / BM; nN = N / BM; nwg = nM * nN; G = G_; c = c_; }
    __host__ __device__ bool next(int i, Unit& u) const {
        const long L = (long)i * G + c; if (L >= nwg) return false;
        int wgid = (int)L; { const int q = nwg / NXCD, r = nwg % NXCD, xcd = wgid % NXCD, off = wgid / NXCD; wgid = (xcd < r ? xcd * (q + 1) : r * (q + 1) + (xcd - r) * q) + off; }
        const int nig = WGM * nN, gid = wgid / nig, fm = gid * WGM, gsz = (nM - fm) < WGM ? (nM - fm) : WGM;
        u.pm = fm + ((wgid % nig) % gsz); u.pn = (wgid % nig) / gsz; u.pb = u.pn; u.koff = 0; return true;
    }
    __device__ __forceinline__ void a_ready(const Unit&) const {}
    __device__ __forceinline__ void done(const Unit&) const {}
};


struct GroupedOrder {
    int nM, nN, nwg, G, c; int ts[9];
    __device__ __forceinline__ bool next(int i, Unit& u) const {
        const long L = (long)i * G + c; if (L >= nwg) return false;
        int wgid = (int)L; { const int q = nwg / NXCD, r = nwg % NXCD, xcd = wgid % NXCD, off = wgid / NXCD; wgid = (xcd < r ? xcd * (q + 1) : r * (q + 1) + (xcd - r) * q) + off; }
        const int nig = WGM * nN, gid = wgid / nig, fm = gid * WGM, gsz = (nM - fm) < WGM ? (nM - fm) : WGM;
        u.pm = fm + ((wgid % nig) % gsz); u.pn = (wgid % nig) / gsz;
        int e = 0;
#pragma unroll
        for (int j = 1; j < 8; ++j) e += (u.pm >= ts[j]) ? 1 : 0;
        u.pb = e * nN + u.pn; u.koff = 0; return true;
    }
    __device__ __forceinline__ void a_ready(const Unit&) const {}
    __device__ __forceinline__ void done(const Unit&) const {}
};
struct SplitOrder {
    int pm0, R, nN, NS, KS, nwg, G, c; int ts[9];
    __device__ __forceinline__ bool next(int i, Unit& u) const {
        const long L = (long)i * G + c; if (L >= nwg) return false;
        const int l = (int)L, s = l % NS, q = l / NS;
        u.pn = q % nN; u.pm = pm0 + q / nN; u.koff = s * KS;
        int e = 0;
#pragma unroll
        for (int j = 1; j < 8; ++j) e += (u.pm >= ts[j]) ? 1 : 0;
        u.pb = e * nN + u.pn; return true;
    }
    __device__ __forceinline__ void a_ready(const Unit&) const {}
    __device__ __forceinline__ void done(const Unit&) const {}
};

__device__ __forceinline__ unsigned cvt_pk_bf16(float lo, float hi) { unsigned r; asm volatile("v_cvt_pk_bf16_f32 %0, %1, %2" : "=v"(r) : "v"(lo), "v"(hi)); return r; }
__device__ __forceinline__ float fast_sigmoid(float x) { return __builtin_amdgcn_rcpf(1.0f + __builtin_amdgcn_exp2f(x * -1.4426950408889634f)); }
__device__ __forceinline__ float gelu_tanh(float x) {
    const float t = x * (1.0f + 0.044715f * x * x);
    return x * __builtin_amdgcn_rcpf(1.0f + __builtin_amdgcn_exp2f(t * -2.3022081986f));
}
__device__ __forceinline__ f32x4 gelu4(f32x4 v) { return (f32x4){gelu_tanh(v[0]), gelu_tanh(v[1]), gelu_tanh(v[2]), gelu_tanh(v[3])}; }

struct EpiGeluSplit {
    static constexpr bool PERM = true, AFTER_DRAIN = false;
    bf16_t* O; int ldc; int gelu_tiles;
    __device__ __forceinline__ void operator()(const f32x4 (&acc)[2][2][4][2], const Unit& u, int wr, int wc, int fr, int fq) const {
        const int row0 = u.pm * BM + wr * 64 + fr, col0 = u.pn * BM + wc * 32 + 8 * fq;
        const bool act = u.pn < gelu_tiles;
#pragma unroll
        for (int ai = 0; ai < 2; ++ai)
#pragma unroll
            for (int m = 0; m < 4; ++m) { bf16_t* rowp = O + (size_t)(row0 + ai * HALF + m * 16) * ldc + col0;
#pragma unroll
                for (int bj = 0; bj < 2; ++bj) { f32x4 v0 = acc[ai][bj][m][0], v1 = acc[ai][bj][m][1];
                    if (act) { v0 = gelu4(v0); v1 = gelu4(v1); }
                    u32x4 w; w.x = cvt_pk_bf16(v0[0], v0[1]); w.y = cvt_pk_bf16(v0[2], v0[3]); w.z = cvt_pk_bf16(v1[0], v1[1]); w.w = cvt_pk_bf16(v1[2], v1[3]);
                    *(u32x4*)(rowp + bj * HALF) = w; } }
    }
};
struct EpiRes {
    static constexpr bool PERM = false, AFTER_DRAIN = false;
    const float* base; float* out; int ldc; const float* bias;
    __device__ __forceinline__ void operator()(const f32x4 (&acc)[2][2][4][2], const Unit& u, int wr, int wc, int fr, int fq) const {
        const int row0 = u.pm * BM + wr * 64 + fr, col0 = u.pn * BM + wc * 32 + 4 * fq;
        f32x4 bv[2][2];
#pragma unroll
        for (int bj = 0; bj < 2; ++bj)
#pragma unroll
            for (int n = 0; n < 2; ++n) bv[bj][n] = bias ? *(const f32x4*)(bias + col0 + bj * HALF + n * 16) : (f32x4){0.f, 0.f, 0.f, 0.f};
#pragma unroll
        for (int ai = 0; ai < 2; ++ai)
#pragma unroll
            for (int m = 0; m < 4; ++m) { const size_t off = (size_t)(row0 + ai * HALF + m * 16) * ldc + col0;
#pragma unroll
                for (int bj = 0; bj < 2; ++bj)
#pragma unroll
                    for (int n = 0; n < 2; ++n) { const f32x4 bs = *(const f32x4*)(base + off + bj * HALF + n * 16);
                        *(f32x4*)(out + off + bj * HALF + n * 16) = bs + acc[ai][bj][m][n] + bv[bj][n]; } }
    }
};
template <int MODE> struct EpiGlu {
    static constexpr bool PERM = true, AFTER_DRAIN = false;
    bf16_t* O; int ldo; const float* bias0; const float* bias1;
    __device__ __forceinline__ void operator()(const f32x4 (&acc)[2][2][4][2], const Unit& u, int wr, int wc, int fr, int fq) const {
        const int row0 = u.pm * BM + wr * 64 + fr, ocol = u.pn * HALF + wc * 32 + 8 * fq;
        f32x4 b0[2], b1[2];
#pragma unroll
        for (int n = 0; n < 2; ++n) { b0[n] = (MODE == 1) ? *(const f32x4*)(bias0 + ocol + 4 * n) : (f32x4){0.f, 0.f, 0.f, 0.f}; b1[n] = (MODE == 1) ? *(const f32x4*)(bias1 + ocol + 4 * n) : (f32x4){0.f, 0.f, 0.f, 0.f}; }
#pragma unroll
        for (int ai = 0; ai < 2; ++ai)
#pragma unroll
            for (int m = 0; m < 4; ++m) { bf16_t* rowp = O + (size_t)(row0 + ai * HALF + m * 16) * ldo + ocol;
                f32x4 r[2];
#pragma unroll
                for (int n = 0; n < 2; ++n) { const f32x4 a = acc[ai][0][m][n] + b0[n], b = acc[ai][1][m][n] + b1[n];
#pragma unroll
                    for (int i = 0; i < 4; ++i) r[n][i] = (MODE == 0) ? (a[i] * fast_sigmoid(a[i]) * b[i]) : (a[i] * fast_sigmoid(b[i])); }
                u32x4 w; w.x = cvt_pk_bf16(r[0][0], r[0][1]); w.y = cvt_pk_bf16(r[0][2], r[0][3]); w.z = cvt_pk_bf16(r[1][0], r[1][1]); w.w = cvt_pk_bf16(r[1][2], r[1][3]);
                *(u32x4*)rowp = w; }
    }
};
struct EpiPart {
    static constexpr bool PERM = false, AFTER_DRAIN = false;
    float* P; int pm0, nN, NS, KS;
    __device__ __forceinline__ void operator()(const f32x4 (&acc)[2][2][4][2], const Unit& u, int wr, int wc, int fr, int fq) const {
        float* tile = P + ((size_t)((u.pm - pm0) * nN + u.pn) * NS + u.koff / KS) * (BM * BM);
        const int row0 = wr * 64 + fr, col0 = wc * 32 + 4 * fq;
#pragma unroll
        for (int ai = 0; ai < 2; ++ai)
#pragma unroll
            for (int m = 0; m < 4; ++m) { float* rowp = tile + (size_t)(row0 + ai * HALF + m * 16) * BM + col0;
#pragma unroll
                for (int bj = 0; bj < 2; ++bj)
#pragma unroll
                    for (int n = 0; n < 2; ++n) *(f32x4*)(rowp + bj * HALF + n * 16) = acc[ai][bj][m][n]; }
    }
};
struct EpiScale {
    static constexpr bool PERM = true, AFTER_DRAIN = false;
    bf16_t* O; int ldc; const float* rowscale;
    __device__ __forceinline__ void operator()(const f32x4 (&acc)[2][2][4][2], const Unit& u, int wr, int wc, int fr, int fq) const {
        const int row0 = u.pm * BM + wr * 64 + fr, col0 = u.pn * BM + wc * 32 + 8 * fq;
#pragma unroll
        for (int ai = 0; ai < 2; ++ai)
#pragma unroll
            for (int m = 0; m < 4; ++m) { const int row = row0 + ai * HALF + m * 16; const float s = rowscale[row]; bf16_t* rowp = O + (size_t)row * ldc + col0;
#pragma unroll
                for (int bj = 0; bj < 2; ++bj) { const f32x4 v0 = acc[ai][bj][m][0] * s, v1 = acc[ai][bj][m][1] * s;
                    u32x4 w; w.x = cvt_pk_bf16(v0[0], v0[1]); w.y = cvt_pk_bf16(v0[2], v0[3]); w.z = cvt_pk_bf16(v1[0], v1[1]); w.w = cvt_pk_bf16(v1[2], v1[3]);
                    *(u32x4*)(rowp + bj * HALF) = w; } }
    }
};

template <class Epi, class Sched, bool ALIGN_EPI = false, bool SP2 = false>
__device__ __forceinline__ void gemm_phase(PG8_LAS unsigned char* lds, const Gemm g, const Sched& S, const Epi& E) {
    int tid_l = threadIdx.x; asm volatile("" : "+v"(tid_l));
    const int tid = tid_l, wid = __builtin_amdgcn_readfirstlane(tid >> 6), lane = tid & 63, wr = wid >> 2, wc = wid & 3, fr = lane & 15, fq = lane >> 4;
    const int K = g.K, nt = K / BK;
    unsigned voffA[2], voffB[2];
#pragma unroll
    for (int i = 0; i < 2; ++i) { int R, C; stage_rc(tid * 16 + i * 8192, R, C); const int Rb = Epi::PERM ? ((R & ~31) + perm32(R & 31)) : R;
        voffA[i] = (unsigned)(R * g.ld + C) * 2u; voffB[i] = (unsigned)(Rb * g.ld + C) * 2u; }
    const size_t kstep = (size_t)(BK * 2);
    const size_t hstep = (size_t)HALF * g.ld * 2;
    const size_t tstep = 2 * hstep;
    const unsigned ldsw = (unsigned)wid * 1024u;
    const int aoff = lds_byte(wr * 64 + fr, fq * 8), boff = lds_byte(wc * 32 + fr, fq * 8);
#define PG8_SA(b, h) (((b) * 2 + (h)) * HTB)
#define PG8_SB(b, h) ((4 + (b) * 2 + (h)) * HTB)
#define PG8_STAGE(bufoff, gbase, voff) do { _Pragma("unroll") for (int _i = 0; _i < 2; ++_i) \
        __builtin_amdgcn_global_load_lds((const unsigned*)((const char*)(gbase) + (voff)[_i]), (PG8_LAS unsigned*)(lds + (bufoff) + ldsw + _i * 8192), 16, 0, 0); } while (0)
#define PG8_LDA(dst, b, h) do { _Pragma("unroll") for (int m = 0; m < 4; ++m) _Pragma("unroll") for (int k = 0; k < 2; ++k) dst[m][k] = *(const PG8_LAS bf16x8*)(lds + PG8_SA(b, h) + aoff + m * 2048 + k * 1024); } while (0)
#define PG8_LDB(dst, b, h) do { _Pragma("unroll") for (int n = 0; n < 2; ++n) _Pragma("unroll") for (int k = 0; k < 2; ++k) dst[n][k] = *(const PG8_LAS bf16x8*)(lds + PG8_SB(b, h) + boff + n * 2048 + k * 1024); } while (0)
#define PG8_MMA(ai, bj, At, Bt) do { __builtin_amdgcn_s_setprio(1); _Pragma("unroll") for (int m = 0; m < 4; ++m) _Pragma("unroll") for (int n = 0; n < 2; ++n) _Pragma("unroll") for (int k = 0; k < 2; ++k) \
        acc[ai][bj][m][n] = __builtin_amdgcn_mfma_f32_16x16x32_bf16(Bt[n][k], At[m][k], acc[ai][bj][m][n], 0, 0, 0); __builtin_amdgcn_s_setprio(0); } while (0)
#define PG8_WAIT_V(n) asm volatile("s_waitcnt vmcnt(" #n ")" ::: "memory")
#define PG8_WAIT_L(n) asm volatile("s_waitcnt lgkmcnt(" #n ")" ::: "memory")
#define PG8_BAR __builtin_amdgcn_s_barrier()
#define PG8_SCHED __builtin_amdgcn_sched_barrier(0)
    Unit cur, nxt; int ui = 0;
    if (!S.next(0, cur)) return;
    f32x4 acc[2][2][4][2];
#pragma unroll
    for (int a = 0; a < 2; ++a)
#pragma unroll
        for (int b = 0; b < 2; ++b)
#pragma unroll
            for (int m = 0; m < 4; ++m)
#pragma unroll
                for (int n = 0; n < 2; ++n) acc[a][b][m][n] = (f32x4){0.f, 0.f, 0.f, 0.f};
    bf16x8 At[4][2], B0[2][2], B1[2][2];
    const char* cA = (const char*)g.A + (size_t)cur.pm * tstep + (size_t)cur.koff * 2; const char* cB = (const char*)g.Bt + (size_t)cur.pb * tstep + (size_t)cur.koff * 2;
    S.a_ready(cur);
    if constexpr (SP2) {
        PG8_STAGE(PG8_SB(0, 0), cB, voffB); PG8_STAGE(PG8_SB(0, 1), cB + hstep, voffB); PG8_STAGE(PG8_SA(0, 0), cA, voffA); PG8_STAGE(PG8_SA(0, 1), cA + hstep, voffA);
        if (wr == 1) PG8_BAR;
        PG8_WAIT_V(2); PG8_BAR;
        PG8_STAGE(PG8_SB(1, 0), cB + kstep, voffB); PG8_STAGE(PG8_SA(1, 0), cA + kstep, voffA); PG8_STAGE(PG8_SB(1, 1), cB + hstep + kstep, voffB);
        PG8_WAIT_V(6); PG8_BAR;
    } else {
        PG8_STAGE(PG8_SB(0, 0), cB, voffB); PG8_STAGE(PG8_SA(0, 0), cA, voffA); PG8_STAGE(PG8_SB(0, 1), cB + hstep, voffB); PG8_STAGE(PG8_SA(0, 1), cA + hstep, voffA);
        if (wr == 1) PG8_BAR;
        PG8_WAIT_V(4); PG8_BAR;
        PG8_STAGE(PG8_SB(1, 0), cB + kstep, voffB); PG8_STAGE(PG8_SA(1, 0), cA + kstep, voffA); PG8_STAGE(PG8_SB(1, 1), cB + hstep + kstep, voffB);
        PG8_WAIT_V(6); PG8_BAR;
    }
    for (;;) {
        const bool has_next = S.next(ui + 1, nxt);
        const char* nA = has_next ? (const char*)g.A + (size_t)nxt.pm * tstep + (size_t)nxt.koff * 2 : cA; const char* nB = has_next ? (const char*)g.Bt + (size_t)nxt.pb * tstep + (size_t)nxt.koff * 2 : cB;
        for (int t = 0; t < nt; t += 2) {
            const bool last = (t == nt - 2);
            const char* a1 = cA + (size_t)(t + 1) * kstep;
            const char* a2 = last ? nA : cA + (size_t)(t + 2) * kstep; const char* b2 = last ? nB : cB + (size_t)(t + 2) * kstep;
            const char* a3 = a2 + kstep; const char* b3 = b2 + kstep;
            if (last && has_next) S.a_ready(nxt);
            if constexpr (SP2) {
            PG8_LDB(B0, 0, 0); PG8_LDB(B1, 0, 1); PG8_SCHED; PG8_LDA(At, 0, 0); PG8_STAGE(PG8_SA(1, 1), a1 + hstep, voffA);
            PG8_WAIT_V(8); PG8_WAIT_L(0); PG8_BAR; PG8_MMA(0, 0, At, B0); PG8_MMA(0, 1, At, B1); PG8_BAR; PG8_SCHED;
            PG8_LDA(At, 0, 1); PG8_STAGE(PG8_SB(0, 0), b2, voffB); PG8_STAGE(PG8_SB(0, 1), b2 + hstep, voffB); PG8_STAGE(PG8_SA(0, 0), a2, voffA);
            PG8_WAIT_V(8); PG8_WAIT_L(0); PG8_BAR; PG8_MMA(1, 0, At, B0); PG8_MMA(1, 1, At, B1); PG8_BAR; PG8_SCHED;
            PG8_LDB(B0, 1, 0); PG8_LDB(B1, 1, 1); PG8_SCHED; PG8_LDA(At, 1, 0); PG8_STAGE(PG8_SA(0, 1), a2 + hstep, voffA);
            PG8_WAIT_V(8); PG8_WAIT_L(0); PG8_BAR; PG8_MMA(0, 0, At, B0); PG8_MMA(0, 1, At, B1); PG8_BAR; PG8_SCHED;
            PG8_LDA(At, 1, 1); PG8_STAGE(PG8_SB(1, 0), b3, voffB); PG8_STAGE(PG8_SB(1, 1), b3 + hstep, voffB); PG8_STAGE(PG8_SA(1, 0), a3, voffA);
            PG8_WAIT_V(8); PG8_WAIT_L(0); PG8_BAR; PG8_MMA(1, 0, At, B0); PG8_MMA(1, 1, At, B1); PG8_BAR; PG8_SCHED;
            } else {
            PG8_LDB(B0, 0, 0); PG8_SCHED; PG8_LDA(At, 0, 0); PG8_STAGE(PG8_SA(1, 1), a1 + hstep, voffA);
            PG8_WAIT_L(8); PG8_BAR; PG8_WAIT_L(0); PG8_MMA(0, 0, At, B0); PG8_BAR; PG8_SCHED;
            PG8_LDB(B1, 0, 1); PG8_STAGE(PG8_SB(0, 0), b2, voffB);
            PG8_BAR; PG8_WAIT_L(0); PG8_MMA(0, 1, At, B1); PG8_BAR;
            PG8_LDA(At, 0, 1); PG8_STAGE(PG8_SA(0, 0), a2, voffA);
            PG8_BAR; PG8_WAIT_L(0); PG8_MMA(1, 0, At, B0); PG8_BAR; PG8_SCHED;
            PG8_STAGE(PG8_SB(0, 1), b2 + hstep, voffB);
            PG8_WAIT_V(6); PG8_BAR; PG8_MMA(1, 1, At, B1); PG8_BAR;
            PG8_LDB(B0, 1, 0); PG8_SCHED; PG8_LDA(At, 1, 0); PG8_STAGE(PG8_SA(0, 1), a2 + hstep, voffA);
            PG8_WAIT_L(8); PG8_BAR; PG8_WAIT_L(0); PG8_MMA(0, 0, At, B0); PG8_BAR; PG8_SCHED;
            PG8_LDB(B1, 1, 1); PG8_STAGE(PG8_SB(1, 0), b3, voffB);
            PG8_BAR; PG8_WAIT_L(0); PG8_MMA(0, 1, At, B1); PG8_BAR;
            PG8_LDA(At, 1, 1); PG8_STAGE(PG8_SA(1, 0), a3, voffA);
            PG8_BAR; PG8_WAIT_L(0); PG8_MMA(1, 0, At, B0); PG8_BAR; PG8_SCHED;
            PG8_STAGE(PG8_SB(1, 1), b3 + hstep, voffB);
            PG8_WAIT_V(6); PG8_BAR; PG8_MMA(1, 1, At, B1); PG8_BAR;
            }
        }
        if constexpr (ALIGN_EPI) { if (wr == 0) PG8_BAR; }
        if constexpr (!Epi::AFTER_DRAIN) { E(acc, cur, wr, wc, fr, fq); S.done(cur); }
        if (!has_next) break;
#pragma unroll
        for (int a = 0; a < 2; ++a)
#pragma unroll
            for (int b = 0; b < 2; ++b)
#pragma unroll
                for (int m = 0; m < 4; ++m)
#pragma unroll
                    for (int n = 0; n < 2; ++n) acc[a][b][m][n] = (f32x4){0.f, 0.f, 0.f, 0.f};
        cur = nxt; cA = nA; cB = nB; ++ui;
        if constexpr (ALIGN_EPI) { if (wr == 1) PG8_BAR; }
    }
    PG8_WAIT_V(0);
    if constexpr (!ALIGN_EPI) { if (wr == 0) PG8_BAR; }
    PG8_BAR;
    if constexpr (Epi::AFTER_DRAIN) { E.fused(acc, cur, wr, wc, fr, fq, lds, wid, lane); S.done(cur); }
#undef PG8_SA
#undef PG8_SB
#undef PG8_STAGE
#undef PG8_LDA
#undef PG8_LDB
#undef PG8_MMA
#undef PG8_WAIT_V
#undef PG8_WAIT_L
#undef PG8_BAR
#undef PG8_SCHED
}
}

constexpr int NWAVES = 8;
#ifndef MK_PER_PHASE
#define MK_PER_PHASE 0
#endif

constexpr int BATCH = 4, SEQ = 4096, D = 1024, M = BATCH * SEQ;
constexpr int INE = 1536, AW = 512, NHEAD = 8, HD = 64, CHUNK = 128, BW = 512, NGRP = 4, GD = 128;
constexpr int FFD = 2816, NEXP = 8, FFX = 3584, CONVK = 31;
constexpr float EPS = 1e-6f;
constexpr int MSLOT = 2 * M + NEXP * 256;
constexpr int DNX_FULL = 128, DNX_NS = 7, DNX_KS = 512;
constexpr int NPH = 31;

constexpr size_t MiB = 1u << 20;
constexpr size_t WS_CTL = 0, CTL_ZERO_BYTES = 1 * MiB;
constexpr size_t WS_WE = 1 * MiB, WE_STRIDE = 23 * MiB;
constexpr size_t WE_IN = 0, WE_OUT = 3 * MiB, WE_GU = 5 * MiB, WE_DN = 16 * MiB, WE_SP = 21 * MiB + 512 * 1024, WE_PL = 21 * MiB + 768 * 1024;
constexpr size_t WS_WO = 47 * MiB, WO_STRIDE = 174 * MiB;
constexpr size_t WO_PW1 = 0, WO_PW2 = 4 * MiB, WO_GUX = 6 * MiB, WO_DNX = 118 * MiB;
constexpr size_t WS_H = 395 * MiB;
constexpr size_t WS_HN = 459 * MiB;
constexpr size_t WS_R = 491 * MiB;
constexpr size_t WS_PROJ = WS_R, WS_MIX = WS_R + 48 * MiB, WS_ACT = WS_R + 80 * MiB;
constexpr size_t WS_GLU = WS_R, WS_CV = WS_R + 32 * MiB;
constexpr size_t WS_HP = WS_R, WS_ACTX = WS_R + 68 * MiB, WS_Y = WS_R + 306 * MiB;
constexpr size_t WS_PART = WS_R;
constexpr size_t WS_TOKINFO = 865 * MiB, WS_TOKSLOT = WS_TOKINFO + 256 * 1024, WS_SLOTGATE = WS_TOKSLOT + 128 * 1024, WS_CNTTAB = WS_SLOTGATE + 136 * 1024, WS_END = 866 * MiB;
static_assert(WS_WE + 2 * WE_STRIDE <= WS_WO && WS_WO + 2 * WO_STRIDE <= WS_H && WS_H + (size_t)M * D * 4 <= WS_HN && WS_HN + (size_t)M * D * 2 <= WS_R, "ws map");
static_assert(WS_ACT + (size_t)M * FFD * 2 <= WS_TOKINFO && WS_ACTX + (size_t)MSLOT * FFX * 2 <= WS_Y && WS_Y + (size_t)MSLOT * D * 2 <= WS_TOKINFO && (size_t)MSLOT * D * 2 <= 68 * MiB, "ws map 2");
static_assert(WS_SLOTGATE + (size_t)MSLOT * 4 <= WS_CNTTAB && WS_CNTTAB + (size_t)(M / 64) * NEXP * 4 <= WS_END && WS_END <= 896 * MiB, "ws map 3");
constexpr int CW_TMO = 0, CW_CODE = 1;
constexpr int CW_BAR = 4096;
constexpr int CW_MOE = 8192;

constexpr int RING_OFF = 0, RING_BYTES = 141312;
constexpr int LDSCTL_OFF = RING_BYTES, MISC_OFF = LDSCTL_OFF + 320;
constexpr int LDS_BYTES = 147456;
static_assert(MISC_OFF + 128 <= LDS_BYTES, "LDS map");

#define GAS __attribute__((address_space(1)))
#define LAS __attribute__((address_space(3)))
typedef unsigned short bf16;
typedef unsigned v4u __attribute__((ext_vector_type(4)));
typedef float f32x4 __attribute__((ext_vector_type(4)));
typedef short bf16x8 __attribute__((ext_vector_type(8)));
typedef GAS unsigned gu32;
typedef GAS unsigned long long gu64;
#define RLX_AGENT __ATOMIC_RELAXED, __HIP_MEMORY_SCOPE_AGENT
#define LDS_WAIT() asm volatile("s_waitcnt lgkmcnt(0)" ::: "memory")
#define VM_WAIT() asm volatile("s_waitcnt vmcnt(0)" ::: "memory")
__device__ __forceinline__ unsigned long long rt() { return __builtin_amdgcn_s_memrealtime(); }
__device__ __forceinline__ unsigned f2bf(float f) { unsigned u = __builtin_bit_cast(unsigned, f); return (u + 0x7fffu + ((u >> 16) & 1u)) >> 16; }
__device__ __forceinline__ unsigned pk2(float lo, float hi) { return f2bf(lo) | (f2bf(hi) << 16); }

#define XB_TMO      128
#define XB_XCNT(j)  (256  + 64 * (j))
#define XB_XSUB(j)  (1280 + 64 * (j))
#define XB_XGEN(j)  (2304 + 64 * (j))
#define XB_TOP      3328
#define XB_TOPGEN   3392
#define XCD_BAR_WORDS 3456
#define XB_SPIN_CAP (1u << 18)

__device__ __forceinline__ unsigned xb_ld(unsigned* p)              { return __hip_atomic_load(p, __ATOMIC_RELAXED, __HIP_MEMORY_SCOPE_AGENT); }
__device__ __forceinline__ unsigned xb_add(unsigned* p, unsigned v) { return __hip_atomic_fetch_add(p, v, __ATOMIC_RELAXED, __HIP_MEMORY_SCOPE_AGENT); }
__device__ __forceinline__ unsigned xb_xcc_id() { return (unsigned)__builtin_amdgcn_s_getreg((3 << 11) | 20) & 0xFu; }
#define XB_SPIN(cond, bar) do { unsigned _sp = 0; while (cond) { __builtin_amdgcn_s_sleep(1); \
    if ((++_sp & 255u) == 0u) { if (xb_ld(&(bar)[XB_TMO])) break; if (_sp > XB_SPIN_CAP) { atomicAdd(&(bar)[XB_TMO], 1u); break; } } } } while (0)

struct XcdBarrier {
    unsigned* bar; unsigned x;
    volatile LAS unsigned* st;
};

__device__ __forceinline__ XcdBarrier xcd_barrier_post(unsigned* bar, volatile LAS unsigned* st) {
    XcdBarrier b; b.bar = bar; b.x = xb_xcc_id(); b.st = st;
    if (threadIdx.x == 0) (void)xb_add(&bar[XB_XCNT(b.x)], 1u);
    return b;
}
__device__ __forceinline__ void xcd_barrier_complete(unsigned* bar, unsigned x, unsigned& nloc, unsigned& nx) {
    const unsigned G = gridDim.x * gridDim.y * gridDim.z;
    unsigned sum, cnt, mine, sp = 0u;
    for (;;) {
        sum = 0u; cnt = 0u; mine = 0u;
#pragma unroll 1
        for (unsigned j = 0; j < 16; ++j) { const unsigned c = xb_ld(&bar[XB_XCNT(j)]); sum += c; cnt += (c > 0u) ? 1u : 0u; mine = (j == x) ? c : mine; }
        if (sum == G) break;
        __builtin_amdgcn_s_sleep(1);
        if ((++sp & 255u) == 0u) { if (xb_ld(&bar[XB_TMO])) break; if (sp > XB_SPIN_CAP) { atomicAdd(&bar[XB_TMO], 1u); break; } }
    }
    nloc = mine > 0u ? mine : 1u; nx = cnt > 0u ? cnt : 1u;
}

__device__ __forceinline__ void xcd_barrier(const XcdBarrier& b) {
    asm volatile("s_waitcnt vmcnt(0)" ::: "memory");
    __syncthreads();
    if (threadIdx.x == 0) {
        unsigned* bar = b.bar;
        __builtin_amdgcn_s_waitcnt(0);
        unsigned nloc = b.st[0], nx = b.st[1];
        if (nloc == 0u) { xcd_barrier_complete(bar, b.x, nloc, nx); b.st[0] = nloc; b.st[1] = nx; }
        const unsigned old = xb_add(&bar[XB_XSUB(b.x)], 1u);
        const unsigned gen = old / nloc;
        if (old + 1u == (gen + 1u) * nloc) {
            __builtin_amdgcn_fence(__ATOMIC_RELEASE, "agent");
            asm volatile("s_waitcnt vmcnt(0)" ::: "memory");
            const unsigned og = xb_add(&bar[XB_TOP], 1u);
            const unsigned tg = og / nx;
            if (og + 1u == (tg + 1u) * nx) xb_add(&bar[XB_TOPGEN], 1u);
            else XB_SPIN(xb_ld(&bar[XB_TOPGEN]) == tg, bar);
            __builtin_amdgcn_fence(__ATOMIC_ACQUIRE, "agent");
            xb_add(&bar[XB_XGEN(b.x)], 1u);
            asm volatile("s_waitcnt vmcnt(0)" ::: "memory");
        } else {
            XB_SPIN(xb_ld(&bar[XB_XGEN(b.x)]) == gen, bar);
            __builtin_amdgcn_fence(__ATOMIC_ACQUIRE, "agent");
            asm volatile("s_waitcnt vmcnt(0)" ::: "memory");
        }
    }
    __syncthreads();
}

typedef float f32x2 __attribute__((ext_vector_type(2)));
typedef unsigned u32x2 __attribute__((ext_vector_type(2)));
typedef int i32x4 __attribute__((ext_vector_type(4)));
typedef int i32x2 __attribute__((ext_vector_type(2)));
struct Frame {
    LAS unsigned char* lds;
    volatile LAS unsigned* MISC;
    gu32* ctl;
    int tid, lane, wave;
    int vcu, G;
    const float* const* in;
    unsigned char* ws; float* out;
};
__device__ __forceinline__ float bf_lo(unsigned u) { return __uint_as_float(u << 16); }
__device__ __forceinline__ float bf_hi(unsigned u) { return __uint_as_float(u & 0xffff0000u); }
__device__ __forceinline__ unsigned pkbf(float lo, float hi) { return pg8::cvt_pk_bf16(lo, hi); }
__device__ __forceinline__ float wave_sum(float v) {
#pragma unroll
    for (int o = 1; o < 64; o <<= 1) v += __shfl_xor(v, o);
    return v;
}
__device__ __forceinline__ float dot4(f32x4 a, f32x4 b) { return (a.x * b.x + a.y * b.y) + (a.z * b.z + a.w * b.w); }
__device__ __forceinline__ float silu_f(float x) { return x * pg8::fast_sigmoid(x); }

#define P0_LOAD(R, src, ldn) do { _Pragma("unroll") for (int j_ = 0; j_ < 16; ++j_) R[j_] = __builtin_nontemporal_load((const f32x4*)((src) + (size_t)(4 * j_ + (lane >> 4)) * (ldn) + 4 * (lane & 15))); } while (0)
__device__ __forceinline__ void p0_item_addr(int r, int li, const float* const* kargs, unsigned char* ws, const float*& src, int& ldn, bf16*& dst, int& ldk) {
#define in(k) ({ const float* const* p_ = kargs; asm volatile("" : "+s"(p_)); p_[k]; })
    constexpr int I_IN = 16 * 24, I_OUT = 16 * 16, I_GD = 16 * 44, I_DN = 44 * 16, I_PW1 = 16 * 16  , I_PW2 = 16 * 16, I_GX = 16 * 56  , I_DX = 56 * 16  , I_PL = 4  ;
    unsigned char* we = ws + WS_WE + (size_t)li * WE_STRIDE; unsigned char* wo = ws + WS_WO + (size_t)li * WO_STRIDE;
#define P0_PAIR(Wp, K_, N_, dstp, half, q) do { const int nb_ = (N_) / 64, kb_ = (q) / nb_, n0_ = ((q) % nb_) * 64; src = (Wp) + (size_t)(kb_ * 64) * (N_) + n0_; ldn = (N_); \
        dst = (dstp) + (size_t)((n0_ >> 7) * 256 + (half) * 128 + (n0_ & 127)) * (K_) + kb_ * 64; ldk = (K_); } while (0)
#define P0_PLAIN(Wp, K_, N_, dstp, q) do { const int nb_ = (N_) / 64, kb_ = (q) / nb_, n0_ = ((q) % nb_) * 64; src = (Wp) + (size_t)(kb_ * 64) * (N_) + n0_; ldn = (N_); dst = (dstp) + (size_t)n0_ * (K_) + kb_ * 64; ldk = (K_); } while (0)
    if (r < NEXP * I_GX) { const int e = r / I_GX; P0_PAIR(in(24) + ((size_t)li * NEXP + e) * D * FFX, D, FFX, (bf16*)(wo + WO_GUX) + (size_t)e * 2 * FFX * D, 0, r % I_GX); return; } r -= NEXP * I_GX;
    if (r < NEXP * I_GX) { const int e = r / I_GX; P0_PAIR(in(25) + ((size_t)li * NEXP + e) * D * FFX, D, FFX, (bf16*)(wo + WO_GUX) + (size_t)e * 2 * FFX * D, 1, r % I_GX); return; } r -= NEXP * I_GX;
    if (r < NEXP * I_DX) { const int e = r / I_DX; P0_PLAIN(in(26) + ((size_t)li * NEXP + e) * FFX * D, FFX, D, (bf16*)(wo + WO_DNX) + (size_t)e * D * FFX, r % I_DX); return; } r -= NEXP * I_DX;
    if (r < I_IN) { P0_PLAIN(in(2) + (size_t)li * D * INE, D, INE, (bf16*)(we + WE_IN), r); return; } r -= I_IN;
    if (r < I_OUT) { P0_PLAIN(in(8) + (size_t)li * D * D, D, D, (bf16*)(we + WE_OUT), r); return; } r -= I_OUT;
    if (r < I_GD) { P0_PAIR(in(10) + (size_t)li * D * FFD, D, FFD, (bf16*)(we + WE_GU), 0, r); return; } r -= I_GD;
    if (r < I_GD) { P0_PAIR(in(11) + (size_t)li * D * FFD, D, FFD, (bf16*)(we + WE_GU), 1, r); return; } r -= I_GD;
    if (r < I_DN) { P0_PLAIN(in(12) + (size_t)li * FFD * D, FFD, D, (bf16*)(we + WE_DN), r); return; } r -= I_DN;
    if (r < 2 * I_PW1) { const int half = r / I_PW1, q = r % I_PW1, kb = q / 16, n0 = (q % 16) * 64;
        src = in(14) + (size_t)li * D * 2 * D + (size_t)(kb * 64) * (2 * D) + half * D + n0; ldn = 2 * D; dst = (bf16*)(wo + WO_PW1) + (size_t)((n0 >> 7) * 256 + half * 128 + (n0 & 127)) * D + kb * 64; ldk = D; return; } r -= 2 * I_PW1;
    if (r < I_PW2) { P0_PLAIN(in(20) + (size_t)li * D * D, D, D, (bf16*)(wo + WO_PW2), r); return; } r -= I_PW2;
    { const int g = r / I_PL; P0_PLAIN(in(6) + ((size_t)li * NGRP + g) * GD * GD, GD, GD, (bf16*)(we + WE_PL) + (size_t)g * GD * GD, r % I_PL); }
#undef P0_PAIR
#undef P0_PLAIN
#undef in
}
__device__ __forceinline__ void p0_prologue(Frame& F, const float* const* kargs) {
#define in(k) ({ const float* const* p_ = kargs; asm volatile("" : "+s"(p_)); p_[k]; })
    int tid_l = F.tid; asm volatile("" : "+v"(tid_l)); const int tid = tid_l, lane = tid & 63, wave = __builtin_amdgcn_readfirstlane(tid >> 6); (void)tid; (void)lane; (void)wave;
    LAS float* scr = (LAS float*)(F.lds + RING_OFF + wave * 16640);
    const int gw = F.vcu * NWAVES + wave, NGW = F.G * NWAVES;
    constexpr int I_IN = 16 * 24, I_OUT = 16 * 16, I_GD = 16 * 44, I_DN = 44 * 16, I_PW1 = 16 * 16, I_PW2 = 16 * 16, I_GX = 16 * 56, I_DX = 56 * 16, I_PL = 4;
    constexpr int NIT = I_IN + I_OUT + 2 * I_GD + I_DN + 2 * I_PW1 + I_PW2 + NEXP * (2 * I_GX + I_DX) + NGRP * I_PL;
    int it = gw;
    const float* src = nullptr; int ldn = 0; bf16* dst = nullptr; int ldk = 0;
    f32x4 A[16], B[16];
    if (it < 2 * NIT) { p0_item_addr(it % NIT, it / NIT, kargs, F.ws, src, ldn, dst, ldk); P0_LOAD(A, src, ldn); }
    while (it < 2 * NIT) {
        const int itn = it + NGW; const bool hn = itn < 2 * NIT;
        const float* src1 = nullptr; int ldn1 = 0; bf16* dst1 = nullptr; int ldk1 = 0;
        if (hn) { p0_item_addr(itn % NIT, itn / NIT, kargs, F.ws, src1, ldn1, dst1, ldk1); P0_LOAD(B, src1, ldn1); }
#pragma unroll
        for (int j = 0; j < 16; ++j) { LAS float* p = scr + (4 * j + (lane >> 4)) * 65 + 4 * (lane & 15); p[0] = A[j].x; p[1] = A[j].y; p[2] = A[j].z; p[3] = A[j].w; }
        LDS_WAIT(); asm volatile("" ::: "memory");
        { const int c = lane & 7;
#pragma unroll
          for (int j = 0; j < 8; ++j) { const int n = (lane >> 3) + 8 * j; const LAS float* s = scr + (8 * c) * 65 + n;
              v4u o; o.x = pkbf(s[0 * 65], s[1 * 65]); o.y = pkbf(s[2 * 65], s[3 * 65]); o.z = pkbf(s[4 * 65], s[5 * 65]); o.w = pkbf(s[6 * 65], s[7 * 65]);
              *(GAS v4u*)(dst + (size_t)n * ldk + 8 * c) = o; } }
        LDS_WAIT(); asm volatile("" ::: "memory");
        if (hn) {
#pragma unroll
            for (int j = 0; j < 16; ++j) A[j] = B[j];
            dst = dst1; ldk = ldk1; }
        it = itn;
    }
    for (int li = 0; li < 2; ++li) { const float* wsp = in(4) + (size_t)li * NHEAD * CHUNK * CHUNK; bf16* dsp = (bf16*)(F.ws + WS_WE + (size_t)li * WE_STRIDE + WE_SP);
        for (int q = (F.vcu * NWAVES * 64 + tid); q < NHEAD * CHUNK * CHUNK / 4; q += F.G * NWAVES * 64) {
            const int e0 = q * 4, t = (e0 >> 7) & 127, s = e0 & 127; const f32x4 v = *(const f32x4*)(wsp + e0);
            u32x2 o; o.x = pkbf(s + 0 <= t ? v.x : 0.f, s + 1 <= t ? v.y : 0.f); o.y = pkbf(s + 2 <= t ? v.z : 0.f, s + 3 <= t ? v.w : 0.f);
            *(GAS u32x2*)(dsp + e0) = o; } }
#undef in
}
__device__ __forceinline__ void rms_phase(Frame& F, const float* src, const float* gain, bf16* dst) {
    int tid_l = F.tid; asm volatile("" : "+v"(tid_l)); const int tid = tid_l, lane = tid & 63, wave = __builtin_amdgcn_readfirstlane(tid >> 6); (void)tid; (void)lane; (void)wave;
    const int gw = F.vcu * NWAVES + wave, NGW = F.G * NWAVES;
    f32x4 g[4];
#pragma unroll
    for (int j = 0; j < 4; ++j) g[j] = *(const f32x4*)(gain + 4 * lane + 256 * j);
    for (int m = gw; m < M; m += NGW) {
        const GAS f32x4* xr = (const GAS f32x4*)(src + (size_t)m * D) + lane;
        f32x4 v[4]; float s = 0.f;
#pragma unroll
        for (int j = 0; j < 4; ++j) { v[j] = xr[64 * j]; s += dot4(v[j], v[j]); }
        const float rstd = 1.0f / sqrtf(wave_sum(s) * (1.f / D) + EPS);
        GAS u32x2* o8 = (GAS u32x2*)(dst + (size_t)m * D) + lane;
#pragma unroll
        for (int j = 0; j < 4; ++j) { const f32x4 y = v[j] * rstd * g[j]; u32x2 w; w.x = pkbf(y.x, y.y); w.y = pkbf(y.z, y.w); o8[64 * j] = w; }
    }
}
constexpr int TSTR = 272;
__device__ __forceinline__ void mixer_phase(Frame& F, int li, const float* sgu_norm, const float* b_spatial, const float* pool_scale) {
    const bf16* proj = (const bf16*)(F.ws + WS_PROJ); bf16* mix = (bf16*)(F.ws + WS_MIX);
    const bf16* wsp = (const bf16*)(F.ws + WS_WE + (size_t)li * WE_STRIDE + WE_SP); const bf16* wpl = (const bf16*)(F.ws + WS_WE + (size_t)li * WE_STRIDE + WE_PL);
    int tid_l = F.tid; asm volatile("" : "+v"(tid_l)); const int tid = tid_l, lane = tid & 63, wave = __builtin_amdgcn_readfirstlane(tid >> 6); (void)tid; (void)lane; (void)wave;
    const int fr = lane & 15, fq = lane >> 4;
    LAS float* rs = (LAS float*)(F.lds + RING_OFF);
    LAS unsigned char* T = F.lds + RING_OFF + 512 + wave * (64 * TSTR);
    for (int u = F.vcu; u < 2 * (M / CHUNK); u += F.G) {
        const int chunk = u >> 1, part = u & 1, tok0 = chunk * CHUNK;
        if (part == 0) {
            const bf16* vbase = proj + (size_t)tok0 * INE + AW;
#pragma unroll 4
            for (int r = 0; r < 16; ++r) { const int row = wave * 16 + r; const v4u q = *(const GAS v4u*)(vbase + (size_t)row * INE + lane * 8);
                float s = 0.f;
#pragma unroll
                for (int k = 0; k < 4; ++k) { const float a = bf_lo(q[k]), b = bf_hi(q[k]); s += a * a + b * b; }
                s = wave_sum(s); if (lane == 0) rs[row] = 1.0f / sqrtf(s * (1.f / AW) + EPS); }
            __syncthreads();
            const int h = wave, rp = lane >> 3, cg = lane & 7;
            { const f32x4 ga = *(const f32x4*)(sgu_norm + li * AW + h * HD + cg * 8), gb = *(const f32x4*)(sgu_norm + li * AW + h * HD + cg * 8 + 4);
              const float gv[8] = {ga.x, ga.y, ga.z, ga.w, gb.x, gb.y, gb.z, gb.w};
#pragma unroll
              for (int st = 0; st < 8; ++st) { const int s = st * 16 + 2 * rp;
                  const v4u q0 = *(const GAS v4u*)(vbase + (size_t)s * INE + h * HD + cg * 8), q1 = *(const GAS v4u*)(vbase + (size_t)(s + 1) * INE + h * HD + cg * 8);
                  const float r0 = rs[s], r1 = rs[s + 1];
#pragma unroll
                  for (int k = 0; k < 4; ++k) {
                      *(LAS unsigned*)(T + (cg * 8 + 2 * k) * TSTR + s * 2) = pkbf(bf_lo(q0[k]) * r0 * gv[2 * k], bf_lo(q1[k]) * r1 * gv[2 * k]);
                      *(LAS unsigned*)(T + (cg * 8 + 2 * k + 1) * TSTR + s * 2) = pkbf(bf_hi(q0[k]) * r0 * gv[2 * k + 1], bf_hi(q1[k]) * r1 * gv[2 * k + 1]); } } }
            LDS_WAIT(); asm volatile("" ::: "memory");
            const bf16* Wh = wsp + (size_t)h * CHUNK * CHUNK; const float* bs = b_spatial + (li * NHEAD + h) * CHUNK;
#pragma unroll
            for (int ti = 0; ti < 8; ++ti) {
                constexpr int dummy = 0; (void)dummy;
                const int nks = ti / 2 + 1;
                bf16x8 bw[4];
#pragma unroll
                for (int ks = 0; ks < 4; ++ks) if (ks < nks) bw[ks] = *(const GAS bf16x8*)(Wh + (size_t)(16 * ti + fr) * CHUNK + 32 * ks + 8 * fq);
                const int t = 16 * ti + fr; const float bt = bs[t]; const size_t tok = (size_t)tok0 + t;
#pragma unroll
                for (int dj = 0; dj < 4; ++dj) {
                    f32x4 acc = (f32x4){0.f, 0.f, 0.f, 0.f};
#pragma unroll
                    for (int ks = 0; ks < 4; ++ks) if (ks < nks) { const bf16x8 a = *(const LAS bf16x8*)(T + (16 * dj + fr) * TSTR + (32 * ks + 8 * fq) * 2); acc = __builtin_amdgcn_mfma_f32_16x16x32_bf16(a, bw[ks], acc, 0, 0, 0); }
                    const int d = 16 * dj + 4 * fq;
                    const u32x2 uu = *(const GAS u32x2*)(proj + tok * INE + h * HD + d);
                    u32x2 o; o.x = pkbf(bf_lo(uu.x) * (acc[0] + bt), bf_hi(uu.x) * (acc[1] + bt)); o.y = pkbf(bf_lo(uu.y) * (acc[2] + bt), bf_hi(uu.y) * (acc[3] + bt));
                    *(GAS u32x2*)(mix + tok * D + h * HD + d) = o;
                }
            }
        } else {
            const int g = wave >> 1, rh = wave & 1, win = 2 << g;
            const int p0 = (tok0 & (SEQ - 1)) + 64 * rh;
            const size_t tokr = (size_t)tok0 + 64 * rh;
            const bf16* zb = proj + 2 * AW + g * GD + 2 * lane;
            float sx = 0.f, sy = 0.f;
#pragma unroll
            for (int j = 1; j <= 16; ++j) { const bool valid = (j <= win) && (p0 - j >= 0); const size_t row = valid ? tokr - j : tokr;
                const unsigned q = *(const GAS unsigned*)(zb + row * INE); sx += valid ? bf_lo(q) : 0.f; sy += valid ? bf_hi(q) : 0.f; }
#pragma unroll 8
            for (int i = 0; i < 64; ++i) { const bool valid = (p0 + i - win >= 0); const size_t rowo = valid ? tokr + i - win : tokr;
                const unsigned q = *(const GAS unsigned*)(zb + (tokr + i) * INE), qo = *(const GAS unsigned*)(zb + rowo * INE);
                const float zx = bf_lo(q), zy = bf_hi(q);
                sx += zx - (valid ? bf_lo(qo) : 0.f); sy += zy - (valid ? bf_hi(qo) : 0.f);
                const int cnt = (p0 + i + 1 < win) ? (p0 + i + 1) : win; const float inv = 1.0f / (float)cnt;
                *(LAS unsigned*)(T + i * TSTR + lane * 4) = pkbf(sx * inv - zx, sy * inv - zy); }
            LDS_WAIT(); asm volatile("" ::: "memory");
            const bf16* Wp = wpl + (size_t)g * GD * GD;
            bf16x8 bm[4][4];
#pragma unroll
            for (int ti = 0; ti < 4; ++ti)
#pragma unroll
                for (int ks = 0; ks < 4; ++ks) bm[ti][ks] = *(const LAS bf16x8*)(T + (16 * ti + fr) * TSTR + (32 * ks + 8 * fq) * 2);
#pragma unroll 2
            for (int dj = 0; dj < 8; ++dj) {
                bf16x8 aw[4];
#pragma unroll
                for (int ks = 0; ks < 4; ++ks) aw[ks] = *(const GAS bf16x8*)(Wp + (size_t)(16 * dj + fr) * GD + 32 * ks + 8 * fq);
                const f32x4 sc = *(const f32x4*)(pool_scale + li * BW + g * GD + 16 * dj + 4 * fq);
#pragma unroll
                for (int ti = 0; ti < 4; ++ti) {
                    f32x4 acc = (f32x4){0.f, 0.f, 0.f, 0.f};
#pragma unroll
                    for (int ks = 0; ks < 4; ++ks) acc = __builtin_amdgcn_mfma_f32_16x16x32_bf16(aw[ks], bm[ti][ks], acc, 0, 0, 0);
                    u32x2 o; o.x = pkbf(acc[0] * sc.x, acc[1] * sc.y); o.y = pkbf(acc[2] * sc.z, acc[3] * sc.w);
                    *(GAS u32x2*)(mix + (tokr + 16 * ti + fr) * D + AW + g * GD + 16 * dj + 4 * fq) = o;
                }
            }
        }
        __syncthreads();
    }
}
__device__ __forceinline__ void conv_phase(Frame& F, const float* w_dw, const float* b_dw, const float* ln_g, const float* ln_b) {
    const bf16* glu = (const bf16*)(F.ws + WS_GLU); bf16* cvo = (bf16*)(F.ws + WS_CV);
    int tid_l = F.tid; asm volatile("" : "+v"(tid_l)); const int tid = tid_l, lane = tid & 63, wave = __builtin_amdgcn_readfirstlane(tid >> 6); (void)tid; (void)lane; (void)wave;
    const int c0 = 2 * tid;
    LAS float* cv = (LAS float*)(F.lds + RING_OFF);
    f32x2 w[CONVK];
#pragma unroll
    for (int k = 0; k < CONVK; ++k) w[k] = *(const f32x2*)(w_dw + (size_t)k * D + c0);
    const f32x2 bd = *(const f32x2*)(b_dw + c0);
    for (int u = F.vcu; u < M / 16; u += F.G) {
        const int tok0 = u * 16; const bool hist = (tok0 & (SEQ - 1)) != 0;
        unsigned xin[46];
#pragma unroll
        for (int j = 0; j < 46; ++j) { const bool valid = (j >= 30) || hist; const size_t row = valid ? (size_t)(tok0 - 30 + j) : (size_t)tok0;
            const unsigned q = *(const GAS unsigned*)(glu + row * D + c0); xin[j] = valid ? q : 0u; }
        f32x2 acc[16];
#pragma unroll
        for (int i = 0; i < 16; ++i) acc[i] = bd;
#pragma unroll
        for (int j = 0; j < 46; ++j) { const f32x2 x = (f32x2){bf_lo(xin[j]), bf_hi(xin[j])};
#pragma unroll
            for (int i = 0; i < 16; ++i) if (j - i >= 0 && j - i <= 30) acc[i] += w[j - i] * x; }
#pragma unroll
        for (int i = 0; i < 16; ++i) *(LAS f32x2*)(cv + i * D + c0) = acc[i];
        __syncthreads();
#pragma unroll
        for (int rr = 0; rr < 2; ++rr) { const int row = 2 * wave + rr;
            f32x4 v[4]; float s = 0.f;
#pragma unroll
            for (int j = 0; j < 4; ++j) { v[j] = *(const LAS f32x4*)(cv + row * D + 4 * lane + 256 * j); s += (v[j].x + v[j].y) + (v[j].z + v[j].w); }
            const float mean = wave_sum(s) * (1.f / D); float s2 = 0.f;
#pragma unroll
            for (int j = 0; j < 4; ++j) { v[j] = v[j] - mean; s2 += dot4(v[j], v[j]); }
            const float rstd = 1.0f / sqrtf(wave_sum(s2) * (1.f / D) + EPS);
            GAS u32x2* o8 = (GAS u32x2*)(cvo + (size_t)(tok0 + row) * D) + lane;
#pragma unroll
            for (int j = 0; j < 4; ++j) { const f32x4 gg = *(const f32x4*)(ln_g + 4 * lane + 256 * j), bb = *(const f32x4*)(ln_b + 4 * lane + 256 * j);
                const f32x4 y = v[j] * rstd * gg + bb; u32x2 o; o.x = pkbf(silu_f(y.x), silu_f(y.y)); o.y = pkbf(silu_f(y.z), silu_f(y.w)); o8[64 * j] = o; } }
        __syncthreads();
    }
}
__device__ __forceinline__ void router_phase(Frame& F, const float* src, const float* gain, const float* w_router, bf16* dst) {
    int tid_l = F.tid; asm volatile("" : "+v"(tid_l)); const int tid = tid_l, lane = tid & 63, wave = __builtin_amdgcn_readfirstlane(tid >> 6); (void)tid; (void)lane; (void)wave;
    LAS float* wrT = (LAS float*)(F.lds + RING_OFF);
    LAS unsigned* lc = (LAS unsigned*)(F.lds + RING_OFF + 32768);
    for (int c = tid; c < D; c += NWAVES * 64) { const f32x4 a = *(const f32x4*)(w_router + (size_t)c * NEXP), b = *(const f32x4*)(w_router + (size_t)c * NEXP + 4);
        wrT[0 * D + c] = a.x; wrT[1 * D + c] = a.y; wrT[2 * D + c] = a.z; wrT[3 * D + c] = a.w; wrT[4 * D + c] = b.x; wrT[5 * D + c] = b.y; wrT[6 * D + c] = b.z; wrT[7 * D + c] = b.w; }
    f32x4 g[4];
#pragma unroll
    for (int j = 0; j < 4; ++j) g[j] = *(const f32x4*)(gain + 4 * lane + 256 * j);
    i32x4* tokinfo = (i32x4*)(F.ws + WS_TOKINFO); int* cnttab = (int*)(F.ws + WS_CNTTAB);
    for (int u = F.vcu; u < M / 64; u += F.G) {
        if (tid < NEXP) lc[tid] = 0u;
        __syncthreads();
        for (int q = 0; q < 8; ++q) { const int m = u * 64 + wave * 8 + q;
            const GAS f32x4* xr = (const GAS f32x4*)(src + (size_t)m * D) + lane;
            f32x4 v[4]; float s = 0.f;
#pragma unroll
            for (int j = 0; j < 4; ++j) { v[j] = xr[64 * j]; s += dot4(v[j], v[j]); }
            const float rstd = 1.0f / sqrtf(wave_sum(s) * (1.f / D) + EPS);
            GAS u32x2* o8 = (GAS u32x2*)(dst + (size_t)m * D) + lane;
#pragma unroll
            for (int j = 0; j < 4; ++j) { v[j] = v[j] * rstd * g[j]; u32x2 w; w.x = pkbf(v[j].x, v[j].y); w.y = pkbf(v[j].z, v[j].w); o8[64 * j] = w; }
            float lg[NEXP];
#pragma unroll
            for (int e = 0; e < NEXP; ++e) { float p = 0.f;
#pragma unroll
                for (int j = 0; j < 4; ++j) p += dot4(v[j], *(const LAS f32x4*)(wrT + e * D + 4 * lane + 256 * j));
                lg[e] = wave_sum(p); }
            int i1 = 0; float l1 = lg[0];
#pragma unroll
            for (int e = 1; e < NEXP; ++e) if (lg[e] > l1) { l1 = lg[e]; i1 = e; }
            int i2 = -1; float l2 = -INFINITY;
#pragma unroll
            for (int e = 0; e < NEXP; ++e) if (e != i1 && lg[e] > l2) { l2 = lg[e]; i2 = e; }
            const float g1 = 1.0f / (1.0f + __expf(l2 - l1)), g2 = 1.0f - g1;
            if (lane == 0) { tokinfo[m] = (i32x4){i1, i2, (int)__float_as_uint(g1), (int)__float_as_uint(g2)};
                __hip_atomic_fetch_add(&lc[i1], 1u, __ATOMIC_RELAXED, __HIP_MEMORY_SCOPE_WORKGROUP); __hip_atomic_fetch_add(&lc[i2], 1u, __ATOMIC_RELAXED, __HIP_MEMORY_SCOPE_WORKGROUP); }
        }
        __syncthreads();
        if (tid < NEXP) cnttab[u * NEXP + tid] = (int)lc[tid];
    }
}
__device__ __forceinline__ void scatter_phase(Frame& F, gu32* cnt) {
    int tid_l = F.tid; asm volatile("" : "+v"(tid_l)); const int tid = tid_l, lane = tid & 63, wave = __builtin_amdgcn_readfirstlane(tid >> 6); (void)tid; (void)lane; (void)wave;
    const bf16* hn = (const bf16*)(F.ws + WS_HN); bf16* hp = (bf16*)(F.ws + WS_HP);
    const i32x4* tokinfo = (const i32x4*)(F.ws + WS_TOKINFO); i32x2* tokslot = (i32x2*)(F.ws + WS_TOKSLOT); float* slotgate = (float*)(F.ws + WS_SLOTGATE);
    const int* cnttab = (const int*)(F.ws + WS_CNTTAB);
    LAS int* tot = (LAS int*)(F.lds + RING_OFF);
    LAS int* pre = tot + 8;
    LAS int* pbase = tot + 16;
    LAS int* le = tot + 32;
    LAS int* sl = tot + 160;
    for (int u = F.vcu; u < M / 64; u += F.G) {
        const int tok0 = u * 64;
        if (tid < 16) tot[tid] = 0;
        __syncthreads();
        { const int e = tid & 7, part = tid >> 3; int s_all = 0, s_pre = 0;
#pragma unroll
          for (int k = 0; k < (M / 64) / 64; ++k) { const int uu = part * ((M / 64) / 64) + k; const int c = cnttab[uu * NEXP + e]; s_all += c; s_pre += (uu < u) ? c : 0; }
          __hip_atomic_fetch_add(&tot[e], s_all, __ATOMIC_RELAXED, __HIP_MEMORY_SCOPE_WORKGROUP); __hip_atomic_fetch_add(&pre[e], s_pre, __ATOMIC_RELAXED, __HIP_MEMORY_SCOPE_WORKGROUP); }
        i32x4 info = (i32x4){0, 0, 0, 0};
        if (tid < 64) { info = tokinfo[tok0 + tid]; le[2 * tid] = info.x; le[2 * tid + 1] = info.y; }
        __syncthreads();
        if (tid == 0) { int acc = 0;
#pragma unroll
            for (int e = 0; e < NEXP; ++e) { const int t = tot[e]; pbase[e] = acc * 256 + pre[e]; acc += (t + 255) >> 8; if (u == 0) __hip_atomic_store(cnt + 64 * e, (unsigned)t, RLX_AGENT); } }
        __syncthreads();
        if (tid < 64) { int r1 = 0, r2 = 0;
            for (int t = 0; t < tid; ++t) { const int a = le[2 * t], b = le[2 * t + 1]; r1 += (a == info.x) + (b == info.x); r2 += (a == info.y) + (b == info.y); }
            const int s1 = pbase[info.x] + r1, s2 = pbase[info.y] + r2;
            tokslot[tok0 + tid] = (i32x2){s1, s2}; slotgate[s1] = __uint_as_float((unsigned)info.z); slotgate[s2] = __uint_as_float((unsigned)info.w);
            sl[2 * tid] = s1; sl[2 * tid + 1] = s2; }
        __syncthreads();
#pragma unroll 4
        for (int q = 0; q < 8; ++q) { const int tl = wave * 8 + q; const int s1 = sl[2 * tl], s2 = sl[2 * tl + 1];
            const GAS v4u* src = (const GAS v4u*)(hn + (size_t)(tok0 + tl) * D) + lane; const v4u a = src[0], b = src[64];
            GAS v4u* d1 = (GAS v4u*)(hp + (size_t)s1 * D) + lane; GAS v4u* d2 = (GAS v4u*)(hp + (size_t)s2 * D) + lane;
            d1[0] = a; d1[64] = b; d2[0] = a; d2[64] = b; }
        __syncthreads();
    }
}
__device__ __forceinline__ f32x4 y_frag(const bf16* y, const float* part, const float* slotgate, int slot, int j, int lane) {
    if ((slot >> 8) >= DNX_FULL) {
        const float* p = part + ((size_t)(((slot >> 8) - DNX_FULL) * (D / 256) + j) * DNX_NS) * 65536 + (size_t)(slot & 255) * 256 + 4 * lane;
        f32x4 s = *(const GAS f32x4*)p;
#pragma unroll
        for (int sl = 1; sl < DNX_NS; ++sl) s += *(const GAS f32x4*)(p + (size_t)sl * 65536);
        return s * slotgate[slot];
    }
    const u32x2 a = *((const GAS u32x2*)(y + (size_t)slot * D) + lane + 64 * j);
    return (f32x4){bf_lo(a.x), bf_hi(a.x), bf_lo(a.y), bf_hi(a.y)};
}
__device__ __forceinline__ void combine_phase(Frame& F, float* h, const float* gain, bf16* dst, float* fout) {
    int tid_l = F.tid; asm volatile("" : "+v"(tid_l)); const int tid = tid_l, lane = tid & 63, wave = __builtin_amdgcn_readfirstlane(tid >> 6); (void)tid; (void)lane; (void)wave;
    const int gw = F.vcu * NWAVES + wave, NGW = F.G * NWAVES;
    const bf16* y = (const bf16*)(F.ws + WS_Y); const i32x2* tokslot = (const i32x2*)(F.ws + WS_TOKSLOT);
    const float* part = (const float*)(F.ws + WS_PART); const float* slotgate = (const float*)(F.ws + WS_SLOTGATE);
    f32x4 g[4];
#pragma unroll
    for (int j = 0; j < 4; ++j) g[j] = *(const f32x4*)(gain + 4 * lane + 256 * j);
    for (int m = gw; m < M; m += NGW) {
        const i32x2 ss = tokslot[m]; const int s1 = __builtin_amdgcn_readfirstlane(ss.x), s2 = __builtin_amdgcn_readfirstlane(ss.y);
        GAS f32x4* xr = (GAS f32x4*)(h + (size_t)m * D) + lane;
        f32x4 v[4]; float s = 0.f;
#pragma unroll
        for (int j = 0; j < 4; ++j) { v[j] = xr[64 * j] + y_frag(y, part, slotgate, s1, j, lane) + y_frag(y, part, slotgate, s2, j, lane); s += dot4(v[j], v[j]); }
        const float rstd = 1.0f / sqrtf(wave_sum(s) * (1.f / D) + EPS);
        if (fout) { GAS f32x4* o = (GAS f32x4*)(fout + (size_t)m * D) + lane;
#pragma unroll
            for (int j = 0; j < 4; ++j) o[64 * j] = v[j] * rstd * g[j]; }
        else { GAS u32x2* o8 = (GAS u32x2*)(dst + (size_t)m * D) + lane;
#pragma unroll
            for (int j = 0; j < 4; ++j) { xr[64 * j] = v[j]; const f32x4 yv = v[j] * rstd * g[j]; u32x2 w; w.x = pkbf(yv.x, yv.y); w.y = pkbf(yv.z, yv.w); o8[64 * j] = w; } }
    }
}

struct Args { const float* in[28]; float* out; unsigned char* ws; int ph_lo, ph_hi; };
#define PG8_ALIGN true
#define PG8_SP2 true
__global__ void __launch_bounds__(NWAVES * 64, 2) trunk_fwd(Args args) {
    extern __shared__ __attribute__((aligned(16))) unsigned char lds[];
    Frame F;
    F.lds = (LAS unsigned char*)lds;
    F.MISC = (volatile LAS unsigned*)(F.lds + MISC_OFF);
    F.tid = threadIdx.x; F.lane = F.tid & 63; F.wave = __builtin_amdgcn_readfirstlane(F.tid >> 6);
    F.G = gridDim.x; { const int bx = blockIdx.x; F.vcu = (F.G % 8 == 0) ? (bx % 8) * (F.G / 8) + bx / 8 : bx; }
    F.ws = args.ws; F.out = args.out; F.in = nullptr;
    F.ctl = (gu32*)(args.ws + WS_CTL);
    for (int u = F.tid; u < (LDS_BYTES - LDSCTL_OFF) / 4; u += NWAVES * 64) ((LAS unsigned*)(F.lds + LDSCTL_OFF))[u] = 0u;
    __syncthreads();
    XcdBarrier bar = xcd_barrier_post((unsigned*)(F.ctl + CW_BAR), F.MISC + 8);
    const float* const* kargs = (const float* const*)__builtin_amdgcn_kernarg_segment_ptr();
#define INP(k) ({ const float* const* p_ = kargs; asm volatile("" : "+s"(p_)); p_[k]; })
    const int lo = args.ph_lo, hi = args.ph_hi;
    int ph = 0;
#ifndef PHMASK
#define PHMASK 0xffff
#endif
#define EN(k) (((PHMASK) >> (k)) & 1)
#define RUN() (lo <= ph && ph < hi)
#define SEAM() do { if (lo <= ph && ph + 1 < hi) { xcd_barrier(bar); if (PROBE_DUP & 16) { xcd_barrier(bar); xcd_barrier(bar); } } ++ph; } while (0)
    unsigned char* const ws = args.ws;
    float* const H = (float*)(ws + WS_H); bf16* const HN = (bf16*)(ws + WS_HN);

#ifndef PROBE_DUP
#define PROBE_DUP 0
#endif
    if (EN(0) && RUN()) { p0_prologue(F, kargs); if (PROBE_DUP & 1) p0_prologue(F, kargs); rms_phase(F, INP(0), INP(1), HN); }
    SEAM();

#pragma unroll 1
    for (int li = 0; li < 2; ++li) {
        unsigned char* const we = ws + WS_WE + (size_t)li * WE_STRIDE; unsigned char* const wo = ws + WS_WO + (size_t)li * WO_STRIDE;
        if (EN(1) && RUN()) { pg8::Gemm g{HN, (const bf16*)(we + WE_IN), M, INE, D, D}; pg8::StaticOrder S; S.init(M, INE, F.G, (int)blockIdx.x);
            pg8::EpiGeluSplit E{(bf16*)(ws + WS_PROJ), INE, 4};
            pg8::gemm_phase<pg8::EpiGeluSplit, pg8::StaticOrder, PG8_ALIGN, PG8_SP2>(F.lds + RING_OFF, g, S, E); }
        SEAM();
        if (EN(2) && RUN()) { mixer_phase(F, li, INP(3), INP(5), INP(7)); if (PROBE_DUP & 2) mixer_phase(F, li, INP(3), INP(5), INP(7)); }
        SEAM();
        if (EN(3) && RUN()) { pg8::Gemm g{(const bf16*)(ws + WS_MIX), (const bf16*)(we + WE_OUT), M, D, D, D}; pg8::StaticOrder S; S.init(M, D, F.G, (int)blockIdx.x);
            pg8::EpiRes E{li == 0 ? INP(0) : (const float*)H, H, D, nullptr};
            pg8::gemm_phase<pg8::EpiRes, pg8::StaticOrder, PG8_ALIGN, PG8_SP2>(F.lds + RING_OFF, g, S, E); }
        SEAM();
        if (EN(4) && RUN()) { rms_phase(F, H, INP(9) + li * D, HN); if (PROBE_DUP & 4) rms_phase(F, H, INP(9) + li * D, HN); }
        SEAM();
        if (EN(5) && RUN()) { pg8::Gemm g{HN, (const bf16*)(we + WE_GU), M, 2 * FFD, D, D}; pg8::StaticOrder S; S.init(M, 2 * FFD, F.G, (int)blockIdx.x);
            pg8::EpiGlu<0> E{(bf16*)(ws + WS_ACT), FFD, nullptr, nullptr};
            pg8::gemm_phase<pg8::EpiGlu<0>, pg8::StaticOrder, PG8_ALIGN, PG8_SP2>(F.lds + RING_OFF, g, S, E);
            if (PROBE_DUP & 32) { __syncthreads(); pg8::gemm_phase<pg8::EpiGlu<0>, pg8::StaticOrder, PG8_ALIGN, PG8_SP2>(F.lds + RING_OFF, g, S, E); } }
        SEAM();
        if (EN(6) && RUN()) { pg8::Gemm g{(const bf16*)(ws + WS_ACT), (const bf16*)(we + WE_DN), M, D, FFD, FFD}; pg8::StaticOrder S; S.init(M, D, F.G, (int)blockIdx.x);
            pg8::EpiRes E{H, H, D, nullptr};
            pg8::gemm_phase<pg8::EpiRes, pg8::StaticOrder, PG8_ALIGN, PG8_SP2>(F.lds + RING_OFF, g, S, E); }
        SEAM();
        if (EN(7) && RUN()) rms_phase(F, H, INP(13) + li * D, HN);
        SEAM();
        if (EN(8) && RUN()) { pg8::Gemm g{HN, (const bf16*)(wo + WO_PW1), M, 2 * D, D, D}; pg8::StaticOrder S; S.init(M, 2 * D, F.G, (int)blockIdx.x);
            pg8::EpiGlu<1> E{(bf16*)(ws + WS_GLU), D, INP(15) + li * 2 * D, INP(15) + li * 2 * D + D};
            pg8::gemm_phase<pg8::EpiGlu<1>, pg8::StaticOrder, PG8_ALIGN, PG8_SP2>(F.lds + RING_OFF, g, S, E); }
        SEAM();
        if (EN(9) && RUN() && (PROBE_DUP & 8)) conv_phase(F, INP(16) + (size_t)li * CONVK * D, INP(17) + li * D, INP(18) + li * D, INP(19) + li * D);
        if (EN(9) && RUN()) conv_phase(F, INP(16) + (size_t)li * CONVK * D, INP(17) + li * D, INP(18) + li * D, INP(19) + li * D);
        SEAM();
        if (EN(10) && RUN()) { pg8::Gemm g{(const bf16*)(ws + WS_CV), (const bf16*)(wo + WO_PW2), M, D, D, D}; pg8::StaticOrder S; S.init(M, D, F.G, (int)blockIdx.x);
            pg8::EpiRes E{H, H, D, INP(21) + li * D};
            pg8::gemm_phase<pg8::EpiRes, pg8::StaticOrder, PG8_ALIGN, PG8_SP2>(F.lds + RING_OFF, g, S, E); }
        SEAM();
        gu32* const cnt = F.ctl + CW_MOE + li * 1024;
        if (EN(11) && RUN()) router_phase(F, H, INP(22) + li * D, INP(23) + (size_t)li * D * NEXP, HN);
        SEAM();
        if (EN(12) && RUN()) scatter_phase(F, cnt);
        SEAM();
        if (EN(13) && RUN()) { pg8::GroupedOrder S; { int acc = 0; S.ts[0] = 0;
#pragma unroll
                for (int e = 0; e < NEXP; ++e) { const int c = __builtin_amdgcn_readfirstlane((int)__hip_atomic_load(cnt + 64 * e, RLX_AGENT)); acc += (c + 255) >> 8; S.ts[e + 1] = acc; }
                S.nM = acc; S.nN = 2 * FFX / 256; S.nwg = acc * S.nN; S.G = F.G; S.c = (int)blockIdx.x; }
            pg8::Gemm g{(const bf16*)(ws + WS_HP), (const bf16*)(wo + WO_GUX), MSLOT, 2 * FFX, D, D};
            pg8::EpiGlu<0> E{(bf16*)(ws + WS_ACTX), FFX, nullptr, nullptr};
            pg8::gemm_phase<pg8::EpiGlu<0>, pg8::GroupedOrder, PG8_ALIGN, PG8_SP2>(F.lds + RING_OFF, g, S, E); }
        SEAM();
        if (EN(14) && RUN()) { int tsv[9]; int acc = 0; tsv[0] = 0;
#pragma unroll
            for (int e = 0; e < NEXP; ++e) { const int c = __builtin_amdgcn_readfirstlane((int)__hip_atomic_load(cnt + 64 * e, RLX_AGENT)); acc += (c + 255) >> 8; tsv[e + 1] = acc; }
            const int nfull = acc < DNX_FULL ? acc : DNX_FULL;
            { pg8::GroupedOrder S;
#pragma unroll
              for (int e = 0; e < 9; ++e) S.ts[e] = tsv[e];
              S.nM = nfull; S.nN = D / 256; S.nwg = nfull * S.nN; S.G = F.G; S.c = (int)blockIdx.x;
              pg8::Gemm g{(const bf16*)(ws + WS_ACTX), (const bf16*)(wo + WO_DNX), MSLOT, D, FFX, FFX};
              pg8::EpiScale E{(bf16*)(ws + WS_Y), D, (const float*)(ws + WS_SLOTGATE)};
              pg8::gemm_phase<pg8::EpiScale, pg8::GroupedOrder, PG8_ALIGN, PG8_SP2>(F.lds + RING_OFF, g, S, E); }
            __syncthreads();
            { pg8::SplitOrder S;
#pragma unroll
              for (int e = 0; e < 9; ++e) S.ts[e] = tsv[e];
              S.pm0 = DNX_FULL; S.R = acc - nfull; S.nN = D / 256; S.NS = DNX_NS; S.KS = DNX_KS; S.nwg = S.R * S.nN * DNX_NS; S.G = F.G; S.c = (int)blockIdx.x;
              pg8::Gemm g{(const bf16*)(ws + WS_ACTX), (const bf16*)(wo + WO_DNX), MSLOT, D, DNX_KS, FFX};
              pg8::EpiPart E{(float*)(ws + WS_PART), DNX_FULL, D / 256, DNX_NS, DNX_KS};
              pg8::gemm_phase<pg8::EpiPart, pg8::SplitOrder, PG8_ALIGN, PG8_SP2>(F.lds + RING_OFF, g, S, E); } }
        SEAM();
        if (EN(15) && RUN()) combine_phase(F, H, li == 0 ? INP(1) + D : INP(27), HN, li == 0 ? nullptr : args.out);
        SEAM();
    }
#undef RUN
#undef SEAM
}

extern "C" void kernel_launch(void* const* d_in, const int* in_sizes, int n_in, void* d_out, int out_size, void* d_ws, size_t ws_size, hipStream_t stream) {
    static int grid = 0;
    if (grid == 0) {
        if (n_in != 28 || in_sizes[0] != M * D || out_size != M * D || ws_size < WS_END) { fprintf(stderr, "kernel_launch: shape/workspace mismatch (n_in %d, in0 %d, out %d, ws %zu, need %zu); nothing launched\n", n_in, n_in > 0 ? in_sizes[0] : -1, out_size, ws_size, (size_t)WS_END); grid = -1; return; }
        int dev = 0, cus = 0, per_cu = 0;
        if (hipGetDevice(&dev) != hipSuccess || hipDeviceGetAttribute(&cus, hipDeviceAttributeMultiprocessorCount, dev) != hipSuccess) { grid = -1; return; }
        if (hipFuncSetAttribute((const void*)trunk_fwd, hipFuncAttributeMaxDynamicSharedMemorySize, LDS_BYTES) != hipSuccess) { fprintf(stderr, "kernel_launch: hipFuncSetAttribute failed\n"); grid = -1; return; }
        if (hipOccupancyMaxActiveBlocksPerMultiprocessor(&per_cu, (const void*)trunk_fwd, NWAVES * 64, LDS_BYTES) != hipSuccess || per_cu < 1)
            fprintf(stderr, "kernel_launch: note: occupancy query reports %d workgroups per CU\n", per_cu);
        (void)hipGetLastError();
        grid = cus;
    }
    if (grid < 0) return;
    if (hipMemsetAsync((char*)d_ws + WS_CTL, 0, CTL_ZERO_BYTES, stream) != hipSuccess) { fprintf(stderr, "kernel_launch: hipMemsetAsync failed\n"); return; }
    Args a{};
    for (int i = 0; i < 28; ++i) a.in[i] = (const float*)d_in[i];
    a.out = (float*)d_out; a.ws = (unsigned char*)d_ws;
#if MK_PER_PHASE
    for (int p = 0; p < NPH; ++p) { a.ph_lo = p; a.ph_hi = p + 1; hipLaunchKernelGGL(trunk_fwd, dim3(grid), dim3(NWAVES * 64), LDS_BYTES, stream, a); }
#else
    a.ph_lo = 0; a.ph_hi = NPH;
    hipLaunchKernelGGL(trunk_fwd, dim3(grid), dim3(NWAVES * 64), LDS_BYTES, stream, a);
#endif
    const hipError_t le = hipPeekAtLastError();
    if (le != hipSuccess) fprintf(stderr, "kernel_launch: launch failed: %s\n", hipGetErrorName(le));
}
```

```cpp
#include <hip/hip_runtime.h>
#include <cstdio>
#include <cstdint>
#include <cmath>
#ifndef MK_PER_PHASE
#define MK_PER_PHASE 0
#endif
namespace pg8 {
#define PG8_LAS __attribute__((address_space(3)))
typedef unsigned short bf16_t;
typedef short bf16x8 __attribute__((ext_vector_type(8)));
typedef float f32x4 __attribute__((ext_vector_type(4)));
typedef unsigned u32x4 __attribute__((ext_vector_type(4)));
constexpr int BM = 256, BK = 64, HALF = 128, HTB = HALF * BK * 2  , STAGE_BYTES = 8 * HTB, NXCD = 8, WGM = 8;

__host__ __device__ __forceinline__ int lds_byte(int r, int c) { const int st = (r >> 4) * 2 + (c >> 5), rr = r & 15, cc = c & 31, ob = rr * 64 + cc * 2; return st * 1024 + (ob ^ (((ob >> 9) & 1) << 5)); }
__host__ __device__ __forceinline__ void stage_rc(int b, int& R, int& C) { const int st = b / 1024, sb = b % 1024, swz = sb ^ (((sb >> 9) & 1) << 5); R = (st >> 1) * 16 + swz / 64; C = (st & 1) * 32 + (swz % 64) / 2; }
__host__ __device__ __forceinline__ int perm32(int rho) { const int n = rho >> 4, i = rho & 15; return 8 * (i >> 2) + 4 * n + (i & 3); }

struct Unit { int pm, pn, pb, koff; };
struct Gemm { const bf16_t* A; const bf16_t* Bt; int M, N, K, ld; };

struct StaticOrder {
    int nM, nN, nwg, G, c;
    __host__ __device__ void init(int M, int N, int G_, int c_) { nM = M / BM; nN = N / BM; nwg = nM * nN; G = G_; c = c_; }
    __host__ __device__ bool next(int i, Unit& u) const {
        const long L = (long)i * G + c; if (L >= nwg) return false;
        int wgid = (int)L; { const int q = nwg / NXCD, r = nwg % NXCD, xcd = wgid % NXCD, off = wgid / NXCD; wgid = (xcd < r ? xcd * (q + 1) : r * (q + 1) + (xcd - r) * q) + off; }
        const int nig = WGM * nN, gid = wgid / nig, fm = gid * WGM, gsz = (nM - fm) < WGM ? (nM - fm) : WGM;
        u.pm = fm + ((wgid % nig) % gsz); u.pn = (wgid % nig) / gsz; u.pb = u.pn; u.koff = 0; return true;
    }
    __device__ __forceinline__ void a_ready(const Unit&) const {}
    __device__ __forceinline__ void done(const Unit&) const {}
};


struct GroupedOrder {
    int nM, nN, nwg, G, c; int ts[9];
    __device__ __forceinline__ bool next(int i, Unit& u) const {
        const long L = (long)i * G + c; if (L >= nwg) return false;
        int wgid = (int)L; { const int q = nwg / NXCD, r = nwg % NXCD, xcd = wgid % NXCD, off = wgid / NXCD; wgid = (xcd < r ? xcd * (q + 1) : r * (q + 1) + (xcd - r) * q) + off; }
        const int nig = WGM * nN, gid = wgid / nig, fm = gid * WGM, gsz = (nM - fm) < WGM ? (nM - fm) : WGM;
        u.pm = fm + ((wgid % nig) % gsz); u.pn = (wgid % nig) / gsz;
        int e = 0;
#pragma unroll
        for (int j = 1; j < 8; ++j) e += (u.pm >= ts[j]) ? 1 : 0;
        u.pb = e * nN + u.pn; u.koff = 0; return true;
    }
    __device__ __forceinline__ void a_ready(const Unit&) const {}
    __device__ __forceinline__ void done(const Unit&) const {}
};
struct SameTileOrder {
    int nwg, G, c;
    __device__ __forceinline__ bool next(int i, Unit& u) const { const long L = (long)i * G + c; if (L >= nwg) return false; u.pm = 0; u.pn = 0; u.pb = 0; u.koff = 0; return true; }
    __device__ __forceinline__ void a_ready(const Unit&) const {}
    __device__ __forceinline__ void done(const Unit&) const {}
};
struct SplitOrder {
    int pm0, R, nN, NS, KS, nwg, G, c; int ts[9];
    __device__ __forceinline__ bool next(int i, Unit& u) const {
        const long L = (long)i * G + c; if (L >= nwg) return false;
        const int l = (int)L, s = l % NS, q = l / NS;
        u.pn = q % nN; u.pm = pm0 + q / nN; u.koff = s * KS;
        int e = 0;
#pragma unroll
        for (int j = 1; j < 8; ++j) e += (u.pm >= ts[j]) ? 1 : 0;
        u.pb = e * nN + u.pn; return true;
    }
    __device__ __forceinline__ void a_ready(const Unit&) const {}
    __device__ __forceinline__ void done(const Unit&) const {}
};

__device__ __forceinline__ unsigned cvt_pk_bf16(float lo, float hi) { unsigned r; asm volatile("v_cvt_pk_bf16_f32 %0, %1, %2" : "=v"(r) : "v"(lo), "v"(hi)); return r; }
__device__ __forceinline__ float fast_sigmoid(float x) { return __builtin_amdgcn_rcpf(1.0f + __builtin_amdgcn_exp2f(x * -1.4426950408889634f)); }
__device__ __forceinline__ float gelu_tanh(float x) {
    const float t = x * (1.0f + 0.044715f * x * x);
    return x * __builtin_amdgcn_rcpf(1.0f + __builtin_amdgcn_exp2f(t * -2.3022081986f));
}
__device__ __forceinline__ f32x4 gelu4(f32x4 v) { return (f32x4){gelu_tanh(v[0]), gelu_tanh(v[1]), gelu_tanh(v[2]), gelu_tanh(v[3])}; }

struct EpiGeluSplit {
    static constexpr bool PERM = true, AFTER_DRAIN = false;
    bf16_t* O; int ldc; int gelu_tiles;
    __device__ __forceinline__ void operator()(const f32x4 (&acc)[2][2][4][2], const Unit& u, int wr, int wc, int fr, int fq) const {
        const int row0 = u.pm * BM + wr * 64 + fr, col0 = u.pn * BM + wc * 32 + 8 * fq;
        const bool act = u.pn < gelu_tiles;
#pragma unroll
        for (int ai = 0; ai < 2; ++ai)
#pragma unroll
            for (int m = 0; m < 4; ++m) { bf16_t* rowp = O + (size_t)(row0 + ai * HALF + m * 16) * ldc + col0;
#pragma unroll
                for (int bj = 0; bj < 2; ++bj) { f32x4 v0 = acc[ai][bj][m][0], v1 = acc[ai][bj][m][1];
                    if (act) { v0 = gelu4(v0); v1 = gelu4(v1); }
                    u32x4 w; w.x = cvt_pk_bf16(v0[0], v0[1]); w.y = cvt_pk_bf16(v0[2], v0[3]); w.z = cvt_pk_bf16(v1[0], v1[1]); w.w = cvt_pk_bf16(v1[2], v1[3]);
                    *(u32x4*)(rowp + bj * HALF) = w; } }
    }
};
struct EpiRes {
    static constexpr bool PERM = false, AFTER_DRAIN = false;
    const float* base; float* out; int ldc; const float* bias;
    __device__ __forceinline__ void operator()(const f32x4 (&acc)[2][2][4][2], const Unit& u, int wr, int wc, int fr, int fq) const {
        const int row0 = u.pm * BM + wr * 64 + fr, col0 = u.pn * BM + wc * 32 + 4 * fq;
        f32x4 bv[2][2];
#pragma unroll
        for (int bj = 0; bj < 2; ++bj)
#pragma unroll
            for (int n = 0; n < 2; ++n) bv[bj][n] = bias ? *(const f32x4*)(bias + col0 + bj * HALF + n * 16) : (f32x4){0.f, 0.f, 0.f, 0.f};
#pragma unroll
        for (int ai = 0; ai < 2; ++ai) {
            f32x4 pre[4][2][2];
#pragma unroll
            for (int m = 0; m < 4; ++m) { const size_t off = (size_t)(row0 + ai * HALF + m * 16) * ldc + col0;
#pragma unroll
                for (int bj = 0; bj < 2; ++bj)
#pragma unroll
                    for (int n = 0; n < 2; ++n) pre[m][bj][n] = *(const f32x4*)(base + off + bj * HALF + n * 16); }
#pragma unroll
            for (int m = 0; m < 4; ++m) { const size_t off = (size_t)(row0 + ai * HALF + m * 16) * ldc + col0;
#pragma unroll
                for (int bj = 0; bj < 2; ++bj)
#pragma unroll
                    for (int n = 0; n < 2; ++n) *(f32x4*)(out + off + bj * HALF + n * 16) = pre[m][bj][n] + acc[ai][bj][m][n] + bv[bj][n]; }
        }
    }
};
template <int MODE> struct EpiGlu {
    static constexpr bool PERM = true, AFTER_DRAIN = false;
    bf16_t* O; int ldo; const float* bias0; const float* bias1;
    __device__ __forceinline__ void operator()(const f32x4 (&acc)[2][2][4][2], const Unit& u, int wr, int wc, int fr, int fq) const {
        const int row0 = u.pm * BM + wr * 64 + fr, ocol = u.pn * HALF + wc * 32 + 8 * fq;
        f32x4 b0[2], b1[2];
#pragma unroll
        for (int n = 0; n < 2; ++n) { b0[n] = (MODE == 1) ? *(const f32x4*)(bias0 + ocol + 4 * n) : (f32x4){0.f, 0.f, 0.f, 0.f}; b1[n] = (MODE == 1) ? *(const f32x4*)(bias1 + ocol + 4 * n) : (f32x4){0.f, 0.f, 0.f, 0.f}; }
#pragma unroll
        for (int ai = 0; ai < 2; ++ai)
#pragma unroll
            for (int m = 0; m < 4; ++m) { bf16_t* rowp = O + (size_t)(row0 + ai * HALF + m * 16) * ldo + ocol;
                f32x4 r[2];
#pragma unroll
                for (int n = 0; n < 2; ++n) { const f32x4 a = acc[ai][0][m][n] + b0[n], b = acc[ai][1][m][n] + b1[n];
#pragma unroll
                    for (int i = 0; i < 4; ++i) r[n][i] = (MODE == 0) ? (a[i] * fast_sigmoid(a[i]) * b[i]) : (a[i] * fast_sigmoid(b[i])); }
                u32x4 w; w.x = cvt_pk_bf16(r[0][0], r[0][1]); w.y = cvt_pk_bf16(r[0][2], r[0][3]); w.z = cvt_pk_bf16(r[1][0], r[1][1]); w.w = cvt_pk_bf16(r[1][2], r[1][3]);
                *(u32x4*)rowp = w; }
    }
};
struct EpiPart {
    static constexpr bool PERM = false, AFTER_DRAIN = false;
    float* P; int pm0, nN, NS, KS;
    __device__ __forceinline__ void operator()(const f32x4 (&acc)[2][2][4][2], const Unit& u, int wr, int wc, int fr, int fq) const {
        float* tile = P + ((size_t)((u.pm - pm0) * nN + u.pn) * NS + u.koff / KS) * (BM * BM);
        const int row0 = wr * 64 + fr, col0 = wc * 32 + 4 * fq;
#pragma unroll
        for (int ai = 0; ai < 2; ++ai)
#pragma unroll
            for (int m = 0; m < 4; ++m) { float* rowp = tile + (size_t)(row0 + ai * HALF + m * 16) * BM + col0;
#pragma unroll
                for (int bj = 0; bj < 2; ++bj)
#pragma unroll
                    for (int n = 0; n < 2; ++n) *(f32x4*)(rowp + bj * HALF + n * 16) = acc[ai][bj][m][n]; }
    }
};
struct EpiScale {
    static constexpr bool PERM = true, AFTER_DRAIN = false;
    bf16_t* O; int ldc; const float* rowscale;
    __device__ __forceinline__ void operator()(const f32x4 (&acc)[2][2][4][2], const Unit& u, int wr, int wc, int fr, int fq) const {
        const int row0 = u.pm * BM + wr * 64 + fr, col0 = u.pn * BM + wc * 32 + 8 * fq;
        float sv[2][4];
#pragma unroll
        for (int ai = 0; ai < 2; ++ai)
#pragma unroll
            for (int m = 0; m < 4; ++m) sv[ai][m] = rowscale[row0 + ai * HALF + m * 16];
#pragma unroll
        for (int ai = 0; ai < 2; ++ai)
#pragma unroll
            for (int m = 0; m < 4; ++m) { const int row = row0 + ai * HALF + m * 16; const float s = sv[ai][m]; bf16_t* rowp = O + (size_t)row * ldc + col0;
#pragma unroll
                for (int bj = 0; bj < 2; ++bj) { const f32x4 v0 = acc[ai][bj][m][0] * s, v1 = acc[ai][bj][m][1] * s;
                    u32x4 w; w.x = cvt_pk_bf16(v0[0], v0[1]); w.y = cvt_pk_bf16(v0[2], v0[3]); w.z = cvt_pk_bf16(v1[0], v1[1]); w.w = cvt_pk_bf16(v1[2], v1[3]);
                    *(u32x4*)(rowp + bj * HALF) = w; } }
    }
};

template <class Epi, class Sched, bool ALIGN_EPI = false, bool SP2 = false>
__device__ __forceinline__ void gemm_phase(PG8_LAS unsigned char* lds, const Gemm g, const Sched& S, const Epi& E) {
    int tid_l = threadIdx.x; asm volatile("" : "+v"(tid_l));
    const int tid = tid_l, wid = __builtin_amdgcn_readfirstlane(tid >> 6), lane = tid & 63, wr = wid >> 2, wc = wid & 3, fr = lane & 15, fq = lane >> 4;
    const int K = g.K, nt = K / BK;
    unsigned voffA[2], voffB[2];
#pragma unroll
    for (int i = 0; i < 2; ++i) { int R, C; stage_rc(tid * 16 + i * 8192, R, C); const int Rb = Epi::PERM ? ((R & ~31) + perm32(R & 31)) : R;
        voffA[i] = (unsigned)(R * g.ld + C) * 2u; voffB[i] = (unsigned)(Rb * g.ld + C) * 2u; }
    const size_t kstep = (size_t)(BK * 2);
    const size_t hstep = (size_t)HALF * g.ld * 2;
    const size_t tstep = 2 * hstep;
    const unsigned ldsw = (unsigned)wid * 1024u;
    const int aoff = lds_byte(wr * 64 + fr, fq * 8), boff = lds_byte(wc * 32 + fr, fq * 8);
#define PG8_SA(b, h) (((b) * 2 + (h)) * HTB)
#define PG8_SB(b, h) ((4 + (b) * 2 + (h)) * HTB)
#define PG8_STAGE(bufoff, gbase, voff) do { _Pragma("unroll") for (int _i = 0; _i < 2; ++_i) \
        __builtin_amdgcn_global_load_lds((const unsigned*)((const char*)(gbase) + (voff)[_i]), (PG8_LAS unsigned*)(lds + (bufoff) + ldsw + _i * 8192), 16, 0, 0); } while (0)
#define PG8_LDA(dst, b, h) do { _Pragma("unroll") for (int m = 0; m < 4; ++m) _Pragma("unroll") for (int k = 0; k < 2; ++k) dst[m][k] = *(const PG8_LAS bf16x8*)(lds + PG8_SA(b, h) + aoff + m * 2048 + k * 1024); } while (0)
#define PG8_LDB(dst, b, h) do { _Pragma("unroll") for (int n = 0; n < 2; ++n) _Pragma("unroll") for (int k = 0; k < 2; ++k) dst[n][k] = *(const PG8_LAS bf16x8*)(lds + PG8_SB(b, h) + boff + n * 2048 + k * 1024); } while (0)
#define PG8_MMA(ai, bj, At, Bt) do { __builtin_amdgcn_s_setprio(1); _Pragma("unroll") for (int m = 0; m < 4; ++m) _Pragma("unroll") for (int n = 0; n < 2; ++n) _Pragma("unroll") for (int k = 0; k < 2; ++k) \
        acc[ai][bj][m][n] = __builtin_amdgcn_mfma_f32_16x16x32_bf16(Bt[n][k], At[m][k], acc[ai][bj][m][n], 0, 0, 0); __builtin_amdgcn_s_setprio(0); } while (0)
#define PG8_WAIT_V(n) asm volatile("s_waitcnt vmcnt(" #n ")" ::: "memory")
#define PG8_WAIT_L(n) asm volatile("s_waitcnt lgkmcnt(" #n ")" ::: "memory")
#define PG8_BAR __builtin_amdgcn_s_barrier()
#define PG8_SCHED __builtin_amdgcn_sched_barrier(0)
    Unit cur, nxt; int ui = 0;
    if (!S.next(0, cur)) return;
    f32x4 acc[2][2][4][2];
#pragma unroll
    for (int a = 0; a < 2; ++a)
#pragma unroll
        for (int b = 0; b < 2; ++b)
#pragma unroll
            for (int m = 0; m < 4; ++m)
#pragma unroll
                for (int n = 0; n < 2; ++n) acc[a][b][m][n] = (f32x4){0.f, 0.f, 0.f, 0.f};
    bf16x8 At[4][2], B0[2][2], B1[2][2];
    const char* cA = (const char*)g.A + (size_t)cur.pm * tstep + (size_t)cur.koff * 2; const char* cB = (const char*)g.Bt + (size_t)cur.pb * tstep + (size_t)cur.koff * 2;
    S.a_ready(cur);
    if constexpr (SP2) {
        PG8_STAGE(PG8_SB(0, 0), cB, voffB); PG8_STAGE(PG8_SB(0, 1), cB + hstep, voffB); PG8_STAGE(PG8_SA(0, 0), cA, voffA); PG8_STAGE(PG8_SA(0, 1), cA + hstep, voffA);
        if (wr == 1) PG8_BAR;
        PG8_WAIT_V(2); PG8_BAR;
        PG8_STAGE(PG8_SB(1, 0), cB + kstep, voffB); PG8_STAGE(PG8_SA(1, 0), cA + kstep, voffA); PG8_STAGE(PG8_SB(1, 1), cB + hstep + kstep, voffB);
        PG8_WAIT_V(6); PG8_BAR;
    } else {
        PG8_STAGE(PG8_SB(0, 0), cB, voffB); PG8_STAGE(PG8_SA(0, 0), cA, voffA); PG8_STAGE(PG8_SB(0, 1), cB + hstep, voffB); PG8_STAGE(PG8_SA(0, 1), cA + hstep, voffA);
        if (wr == 1) PG8_BAR;
        PG8_WAIT_V(4); PG8_BAR;
        PG8_STAGE(PG8_SB(1, 0), cB + kstep, voffB); PG8_STAGE(PG8_SA(1, 0), cA + kstep, voffA); PG8_STAGE(PG8_SB(1, 1), cB + hstep + kstep, voffB);
        PG8_WAIT_V(6); PG8_BAR;
    }
    for (;;) {
        const bool has_next = S.next(ui + 1, nxt);
        const char* nA = has_next ? (const char*)g.A + (size_t)nxt.pm * tstep + (size_t)nxt.koff * 2 : cA; const char* nB = has_next ? (const char*)g.Bt + (size_t)nxt.pb * tstep + (size_t)nxt.koff * 2 : cB;
        for (int t = 0; t < nt; t += 2) {
            const bool last = (t == nt - 2);
            const char* a1 = cA + (size_t)(t + 1) * kstep;
            const char* a2 = last ? nA : cA + (size_t)(t + 2) * kstep; const char* b2 = last ? nB : cB + (size_t)(t + 2) * kstep;
            const char* a3 = a2 + kstep; const char* b3 = b2 + kstep;
            if (last && has_next) S.a_ready(nxt);
            if constexpr (SP2) {
            PG8_LDB(B0, 0, 0); PG8_LDB(B1, 0, 1); PG8_SCHED; PG8_LDA(At, 0, 0); PG8_STAGE(PG8_SA(1, 1), a1 + hstep, voffA);
            PG8_WAIT_V(8); PG8_WAIT_L(0); PG8_BAR; PG8_MMA(0, 0, At, B0); PG8_MMA(0, 1, At, B1); PG8_BAR; PG8_SCHED;
            PG8_LDA(At, 0, 1); PG8_STAGE(PG8_SB(0, 0), b2, voffB); PG8_STAGE(PG8_SB(0, 1), b2 + hstep, voffB); PG8_STAGE(PG8_SA(0, 0), a2, voffA);
            PG8_WAIT_V(8); PG8_WAIT_L(0); PG8_BAR; PG8_MMA(1, 0, At, B0); PG8_MMA(1, 1, At, B1); PG8_BAR; PG8_SCHED;
            PG8_LDB(B0, 1, 0); PG8_LDB(B1, 1, 1); PG8_SCHED; PG8_LDA(At, 1, 0); PG8_STAGE(PG8_SA(0, 1), a2 + hstep, voffA);
            PG8_WAIT_V(8); PG8_WAIT_L(0); PG8_BAR; PG8_MMA(0, 0, At, B0); PG8_MMA(0, 1, At, B1); PG8_BAR; PG8_SCHED;
            PG8_LDA(At, 1, 1); PG8_STAGE(PG8_SB(1, 0), b3, voffB); PG8_STAGE(PG8_SB(1, 1), b3 + hstep, voffB); PG8_STAGE(PG8_SA(1, 0), a3, voffA);
            PG8_WAIT_V(8); PG8_WAIT_L(0); PG8_BAR; PG8_MMA(1, 0, At, B0); PG8_MMA(1, 1, At, B1); PG8_BAR; PG8_SCHED;
            } else {
            PG8_LDB(B0, 0, 0); PG8_SCHED; PG8_LDA(At, 0, 0); PG8_STAGE(PG8_SA(1, 1), a1 + hstep, voffA);
            PG8_WAIT_L(8); PG8_BAR; PG8_WAIT_L(0); PG8_MMA(0, 0, At, B0); PG8_BAR; PG8_SCHED;
            PG8_LDB(B1, 0, 1); PG8_STAGE(PG8_SB(0, 0), b2, voffB);
            PG8_BAR; PG8_WAIT_L(0); PG8_MMA(0, 1, At, B1); PG8_BAR;
            PG8_LDA(At, 0, 1); PG8_STAGE(PG8_SA(0, 0), a2, voffA);
            PG8_BAR; PG8_WAIT_L(0); PG8_MMA(1, 0, At, B0); PG8_BAR; PG8_SCHED;
            PG8_STAGE(PG8_SB(0, 1), b2 + hstep, voffB);
            PG8_WAIT_V(6); PG8_BAR; PG8_MMA(1, 1, At, B1); PG8_BAR;
            PG8_LDB(B0, 1, 0); PG8_SCHED; PG8_LDA(At, 1, 0); PG8_STAGE(PG8_SA(0, 1), a2 + hstep, voffA);
            PG8_WAIT_L(8); PG8_BAR; PG8_WAIT_L(0); PG8_MMA(0, 0, At, B0); PG8_BAR; PG8_SCHED;
            PG8_LDB(B1, 1, 1); PG8_STAGE(PG8_SB(1, 0), b3, voffB);
            PG8_BAR; PG8_WAIT_L(0); PG8_MMA(0, 1, At, B1); PG8_BAR;
            PG8_LDA(At, 1, 1); PG8_STAGE(PG8_SA(1, 0), a3, voffA);
            PG8_BAR; PG8_WAIT_L(0); PG8_MMA(1, 0, At, B0); PG8_BAR; PG8_SCHED;
            PG8_STAGE(PG8_SB(1, 1), b3 + hstep, voffB);
            PG8_WAIT_V(6); PG8_BAR; PG8_MMA(1, 1, At, B1); PG8_BAR;
            }
        }
        if constexpr (ALIGN_EPI) { if (wr == 0) PG8_BAR; }
        if constexpr (!Epi::AFTER_DRAIN) { E(acc, cur, wr, wc, fr, fq); S.done(cur); }
        if (!has_next) break;
#pragma unroll
        for (int a = 0; a < 2; ++a)
#pragma unroll
            for (int b = 0; b < 2; ++b)
#pragma unroll
                for (int m = 0; m < 4; ++m)
#pragma unroll
                    for (int n = 0; n < 2; ++n) acc[a][b][m][n] = (f32x4){0.f, 0.f, 0.f, 0.f};
        cur = nxt; cA = nA; cB = nB; ++ui;
        if constexpr (ALIGN_EPI) { if (wr == 1) PG8_BAR; }
    }
    PG8_WAIT_V(0);
    if constexpr (!ALIGN_EPI) { if (wr == 0) PG8_BAR; }
    PG8_BAR;
    if constexpr (Epi::AFTER_DRAIN) { E.fused(acc, cur, wr, wc, fr, fq, lds, wid, lane); S.done(cur); }
#undef PG8_SA
#undef PG8_SB
#undef PG8_STAGE
#undef PG8_LDA
#undef PG8_LDB
#undef PG8_MMA
#undef PG8_WAIT_V
#undef PG8_WAIT_L
#undef PG8_BAR
#undef PG8_SCHED
}
}

constexpr int NWAVES = 8;
#ifndef MK_PER_PHASE
#define MK_PER_PHASE 0
#endif

constexpr int BATCH = 4, SEQ = 4096, D = 1024, M = BATCH * SEQ;
constexpr int INE = 1536, AW = 512, NHEAD = 8, HD = 64, CHUNK = 128, BW = 512, NGRP = 4, GD = 128;
constexpr int FFD = 2816, NEXP = 8, FFX = 3584, CONVK = 31;
constexpr float EPS = 1e-6f;
constexpr int MSLOT = 2 * M + NEXP * 256;
constexpr int DNX_FULL = 128, DNX_NS = 7, DNX_KS = 512;
constexpr int NPH = 31;

constexpr size_t MiB = 1u << 20;
constexpr size_t WS_CTL = 0, CTL_ZERO_BYTES = 1 * MiB;
constexpr size_t WS_WE = 1 * MiB, WE_STRIDE = 23 * MiB;
constexpr size_t WE_IN = 0, WE_OUT = 3 * MiB, WE_GU = 5 * MiB, WE_DN = 16 * MiB, WE_SP = 21 * MiB + 512 * 1024, WE_PL = 21 * MiB + 768 * 1024;
constexpr size_t WS_WO = 47 * MiB, WO_STRIDE = 174 * MiB;
constexpr size_t WO_PW1 = 0, WO_PW2 = 4 * MiB, WO_GUX = 6 * MiB, WO_DNX = 118 * MiB;
constexpr size_t WS_H = 395 * MiB;
constexpr size_t WS_HN = 459 * MiB;
constexpr size_t WS_R = 491 * MiB;
constexpr size_t WS_PROJ = WS_R, WS_MIX = WS_R + 48 * MiB, WS_ACT = WS_R + 80 * MiB;
constexpr size_t WS_GLU = WS_R, WS_CV = WS_R + 32 * MiB;
constexpr size_t WS_HP = WS_R, WS_ACTX = WS_R + 68 * MiB, WS_Y = WS_R + 306 * MiB;
constexpr size_t WS_PART = WS_R;
constexpr size_t WS_TOKINFO = 865 * MiB, WS_TOKSLOT = WS_TOKINFO + 256 * 1024, WS_SLOTGATE = WS_TOKSLOT + 128 * 1024, WS_CNTTAB = WS_SLOTGATE + 136 * 1024, WS_END = 866 * MiB;
static_assert(WS_WE + 2 * WE_STRIDE <= WS_WO && WS_WO + 2 * WO_STRIDE <= WS_H && WS_H + (size_t)M * D * 4 <= WS_HN && WS_HN + (size_t)M * D * 2 <= WS_R, "ws map");
static_assert(WS_ACT + (size_t)M * FFD * 2 <= WS_TOKINFO && WS_ACTX + (size_t)MSLOT * FFX * 2 <= WS_Y && WS_Y + (size_t)MSLOT * D * 2 <= WS_TOKINFO && (size_t)MSLOT * D * 2 <= 68 * MiB, "ws map 2");
static_assert(WS_SLOTGATE + (size_t)MSLOT * 4 <= WS_CNTTAB && WS_CNTTAB + (size_t)(M / 64) * NEXP * 4 <= WS_END && WS_END <= 896 * MiB, "ws map 3");
constexpr int CW_TMO = 0, CW_CODE = 1;
constexpr int CW_BAR = 4096;
constexpr int CW_CONVQ = 7936;
constexpr int CW_CONVSNAP = 7680;
constexpr int CW_MOE = 8192;

constexpr int RING_OFF = 0, RING_BYTES = 141312;
constexpr int LDSCTL_OFF = RING_BYTES, MISC_OFF = LDSCTL_OFF + 320;
constexpr int LDS_BYTES = 147456;
static_assert(MISC_OFF + 128 <= LDS_BYTES, "LDS map");

#define GAS __attribute__((address_space(1)))
#define LAS __attribute__((address_space(3)))
typedef unsigned short bf16;
typedef unsigned v4u __attribute__((ext_vector_type(4)));
typedef float f32x4 __attribute__((ext_vector_type(4)));
typedef short bf16x8 __attribute__((ext_vector_type(8)));
typedef GAS unsigned gu32;
typedef GAS unsigned long long gu64;
#define RLX_AGENT __ATOMIC_RELAXED, __HIP_MEMORY_SCOPE_AGENT
#define LDS_WAIT() asm volatile("s_waitcnt lgkmcnt(0)" ::: "memory")
#define VM_WAIT() asm volatile("s_waitcnt vmcnt(0)" ::: "memory")
__device__ __forceinline__ unsigned long long rt() { return __builtin_amdgcn_s_memrealtime(); }
__device__ __forceinline__ unsigned f2bf(float f) { unsigned u = __builtin_bit_cast(unsigned, f); return (u + 0x7fffu + ((u >> 16) & 1u)) >> 16; }
__device__ __forceinline__ unsigned pk2(float lo, float hi) { return f2bf(lo) | (f2bf(hi) << 16); }

#define XB_TMO      128
#define XB_XCNT(j)  (256  + 64 * (j))
#define XB_XSUB(j)  (1280 + 64 * (j))
#define XB_XGEN(j)  (2304 + 64 * (j))
#define XB_TOP      3328
#define XB_TOPGEN   3392
#define XCD_BAR_WORDS 3456
#define XB_SPIN_CAP (1u << 18)

__device__ __forceinline__ unsigned xb_ld(unsigned* p)              { return __hip_atomic_load(p, __ATOMIC_RELAXED, __HIP_MEMORY_SCOPE_AGENT); }
__device__ __forceinline__ unsigned xb_add(unsigned* p, unsigned v) { return __hip_atomic_fetch_add(p, v, __ATOMIC_RELAXED, __HIP_MEMORY_SCOPE_AGENT); }
__device__ __forceinline__ unsigned xb_xcc_id() { return (unsigned)__builtin_amdgcn_s_getreg((3 << 11) | 20) & 0xFu; }
#define XB_SPIN(cond, bar) do { unsigned _sp = 0; while (cond) { __builtin_amdgcn_s_sleep(1); \
    if ((++_sp & 255u) == 0u) { if (xb_ld(&(bar)[XB_TMO])) break; if (_sp > XB_SPIN_CAP) { atomicAdd(&(bar)[XB_TMO], 1u); break; } } } } while (0)

struct XcdBarrier {
    unsigned* bar; unsigned x;
    volatile LAS unsigned* st;
};

__device__ __forceinline__ XcdBarrier xcd_barrier_post(unsigned* bar, volatile LAS unsigned* st) {
    XcdBarrier b; b.bar = bar; b.x = xb_xcc_id(); b.st = st;
    if (threadIdx.x == 0) (void)xb_add(&bar[XB_XCNT(b.x)], 1u);
    return b;
}
__device__ __forceinline__ void xcd_barrier_complete(unsigned* bar, unsigned x, unsigned& nloc, unsigned& nx) {
    const unsigned G = gridDim.x * gridDim.y * gridDim.z;
    unsigned sum, cnt, mine, sp = 0u;
    for (;;) {
        sum = 0u; cnt = 0u; mine = 0u;
#pragma unroll 1
        for (unsigned j = 0; j < 16; ++j) { const unsigned c = xb_ld(&bar[XB_XCNT(j)]); sum += c; cnt += (c > 0u) ? 1u : 0u; mine = (j == x) ? c : mine; }
        if (sum == G) break;
        __builtin_amdgcn_s_sleep(1);
        if ((++sp & 255u) == 0u) { if (xb_ld(&bar[XB_TMO])) break; if (sp > XB_SPIN_CAP) { atomicAdd(&bar[XB_TMO], 1u); break; } }
    }
    nloc = mine > 0u ? mine : 1u; nx = cnt > 0u ? cnt : 1u;
}

__device__ __forceinline__ void xcd_barrier(const XcdBarrier& b) {
    asm volatile("s_waitcnt vmcnt(0)" ::: "memory");
    __syncthreads();
    if (threadIdx.x == 0) {
        unsigned* bar = b.bar;
        __builtin_amdgcn_s_waitcnt(0);
        unsigned nloc = b.st[0], nx = b.st[1];
        if (nloc == 0u) { xcd_barrier_complete(bar, b.x, nloc, nx); b.st[0] = nloc; b.st[1] = nx; }
        const unsigned old = xb_add(&bar[XB_XSUB(b.x)], 1u);
        const unsigned gen = old / nloc;
        if (old + 1u == (gen + 1u) * nloc) {
            __builtin_amdgcn_fence(__ATOMIC_RELEASE, "agent");
            asm volatile("s_waitcnt vmcnt(0)" ::: "memory");
            const unsigned og = xb_add(&bar[XB_TOP], 1u);
            const unsigned tg = og / nx;
            if (og + 1u == (tg + 1u) * nx) xb_add(&bar[XB_TOPGEN], 1u);
            else XB_SPIN(xb_ld(&bar[XB_TOPGEN]) == tg, bar);
            __builtin_amdgcn_fence(__ATOMIC_ACQUIRE, "agent");
            xb_add(&bar[XB_XGEN(b.x)], 1u);
            asm volatile("s_waitcnt vmcnt(0)" ::: "memory");
        } else {
            XB_SPIN(xb_ld(&bar[XB_XGEN(b.x)]) == gen, bar);
            __builtin_amdgcn_fence(__ATOMIC_ACQUIRE, "agent");
            asm volatile("s_waitcnt vmcnt(0)" ::: "memory");
        }
    }
    __syncthreads();
}

typedef float f32x2 __attribute__((ext_vector_type(2)));
typedef unsigned u32x2 __attribute__((ext_vector_type(2)));
typedef int i32x4 __attribute__((ext_vector_type(4)));
typedef int i32x2 __attribute__((ext_vector_type(2)));
struct Frame {
    LAS unsigned char* lds;
    volatile LAS unsigned* MISC;
    gu32* ctl;
    int tid, lane, wave;
    int vcu, G;
    const float* const* in;
    unsigned char* ws; float* out;
};
__device__ __forceinline__ float bf_lo(unsigned u) { return __uint_as_float(u << 16); }
__device__ __forceinline__ float bf_hi(unsigned u) { return __uint_as_float(u & 0xffff0000u); }
__device__ __forceinline__ unsigned pkbf(float lo, float hi) { return pg8::cvt_pk_bf16(lo, hi); }
__device__ __forceinline__ float wave_sum(float v) {
#pragma unroll
    for (int o = 1; o < 64; o <<= 1) v += __shfl_xor(v, o);
    return v;
}
__device__ __forceinline__ float dot4(f32x4 a, f32x4 b) { return (a.x * b.x + a.y * b.y) + (a.z * b.z + a.w * b.w); }
__device__ __forceinline__ float silu_f(float x) { return x * pg8::fast_sigmoid(x); }

#define P0_LOAD(R, src, ldn) do { _Pragma("unroll") for (int j_ = 0; j_ < 16; ++j_) R[j_] = __builtin_nontemporal_load((const f32x4*)((src) + (size_t)(4 * j_ + (lane >> 4)) * (ldn) + 4 * (lane & 15))); } while (0)
constexpr int I_IN = 16 * 24, I_OUT = 16 * 16, I_GD = 16 * 44, I_DN = 44 * 16, I_PW1 = 16 * 16  , I_PW2 = 16 * 16, I_GX = 16 * 56  , I_DX = 56 * 16  , I_PL = 4  ;
constexpr int NIT_ST = I_IN + I_OUT + 2 * I_GD + I_DN + 2 * I_PW1 + I_PW2 + NGRP * I_PL, NIT_MOE = NEXP * (2 * I_GX + I_DX), CONV_CHUNK = 4;
static_assert(NIT_MOE % CONV_CHUNK == 0, "queue chunks never straddle a layer pair");
#define KIN(k) ({ const float* const* p_ = kargs; asm volatile("" : "+s"(p_)); p_[k]; })
#define P0_PAIR(Wp, K_, N_, dstp, half, q) do { const int nb_ = (N_) / 64, kb_ = (q) / nb_, n0_ = ((q) % nb_) * 64; src = (Wp) + (size_t)(kb_ * 64) * (N_) + n0_; ldn = (N_); \
        dst = (dstp) + (size_t)((n0_ >> 7) * 256 + (half) * 128 + (n0_ & 127)) * (K_) + kb_ * 64; ldk = (K_); } while (0)
#define P0_PLAIN(Wp, K_, N_, dstp, q) do { const int nb_ = (N_) / 64, kb_ = (q) / nb_, n0_ = ((q) % nb_) * 64; src = (Wp) + (size_t)(kb_ * 64) * (N_) + n0_; ldn = (N_); dst = (dstp) + (size_t)n0_ * (K_) + kb_ * 64; ldk = (K_); } while (0)
template <bool MOE> __device__ __forceinline__ void p0_item_addr(int gidx, const float* const* kargs, unsigned char* ws, const float*& src, int& ldn, bf16*& dst, int& ldk) {
    if constexpr (MOE) {
        const int li = gidx / NIT_MOE; int r = gidx % NIT_MOE; unsigned char* wo = ws + WS_WO + (size_t)li * WO_STRIDE;
        if (r < NEXP * I_GX) { const int e = r / I_GX; P0_PAIR(KIN(24) + ((size_t)li * NEXP + e) * D * FFX, D, FFX, (bf16*)(wo + WO_GUX) + (size_t)e * 2 * FFX * D, 0, r % I_GX); return; } r -= NEXP * I_GX;
        if (r < NEXP * I_GX) { const int e = r / I_GX; P0_PAIR(KIN(25) + ((size_t)li * NEXP + e) * D * FFX, D, FFX, (bf16*)(wo + WO_GUX) + (size_t)e * 2 * FFX * D, 1, r % I_GX); return; } r -= NEXP * I_GX;
        { const int e = r / I_DX; P0_PLAIN(KIN(26) + ((size_t)li * NEXP + e) * FFX * D, FFX, D, (bf16*)(wo + WO_DNX) + (size_t)e * D * FFX, r % I_DX); }
    } else {
        const int li = gidx / NIT_ST; int r = gidx % NIT_ST; unsigned char* we = ws + WS_WE + (size_t)li * WE_STRIDE; unsigned char* wo = ws + WS_WO + (size_t)li * WO_STRIDE;
        if (r < I_IN) { P0_PLAIN(KIN(2) + (size_t)li * D * INE, D, INE, (bf16*)(we + WE_IN), r); return; } r -= I_IN;
        if (r < I_OUT) { P0_PLAIN(KIN(8) + (size_t)li * D * D, D, D, (bf16*)(we + WE_OUT), r); return; } r -= I_OUT;
        if (r < I_GD) { P0_PAIR(KIN(10) + (size_t)li * D * FFD, D, FFD, (bf16*)(we + WE_GU), 0, r); return; } r -= I_GD;
        if (r < I_GD) { P0_PAIR(KIN(11) + (size_t)li * D * FFD, D, FFD, (bf16*)(we + WE_GU), 1, r); return; } r -= I_GD;
        if (r < I_DN) { P0_PLAIN(KIN(12) + (size_t)li * FFD * D, FFD, D, (bf16*)(we + WE_DN), r); return; } r -= I_DN;
        if (r < 2 * I_PW1) { const int half = r / I_PW1, q = r % I_PW1, kb = q / 16, n0 = (q % 16) * 64;
            src = KIN(14) + (size_t)li * D * 2 * D + (size_t)(kb * 64) * (2 * D) + half * D + n0; ldn = 2 * D; dst = (bf16*)(wo + WO_PW1) + (size_t)((n0 >> 7) * 256 + half * 128 + (n0 & 127)) * D + kb * 64; ldk = D; return; } r -= 2 * I_PW1;
        if (r < I_PW2) { P0_PLAIN(KIN(20) + (size_t)li * D * D, D, D, (bf16*)(wo + WO_PW2), r); return; } r -= I_PW2;
        { const int g = r / I_PL; P0_PLAIN(KIN(6) + ((size_t)li * NGRP + g) * GD * GD, GD, GD, (bf16*)(we + WE_PL) + (size_t)g * GD * GD, r % I_PL); }
    }
}
#undef P0_PAIR
#undef P0_PLAIN
template <bool MOE> __device__ __forceinline__ void conv_items(const float* const* kargs, unsigned char* ws, LAS float* scr, int lane, int first, int step, int count) {
    if (count <= 0) return;
    const float* src = nullptr; int ldn = 0; bf16* dst = nullptr; int ldk = 0;
    f32x4 A[16], B[16];
    p0_item_addr<MOE>(first, kargs, ws, src, ldn, dst, ldk); P0_LOAD(A, src, ldn);
    for (int k = 0; k < count; ++k) {
        const bool hn = (k + 1 < count);
        const float* src1 = nullptr; int ldn1 = 0; bf16* dst1 = nullptr; int ldk1 = 0;
        if (hn) { p0_item_addr<MOE>(first + (k + 1) * step, kargs, ws, src1, ldn1, dst1, ldk1); P0_LOAD(B, src1, ldn1); }
#pragma unroll
        for (int j = 0; j < 16; ++j) { LAS float* p = scr + (4 * j + (lane >> 4)) * 65 + 4 * (lane & 15); p[0] = A[j].x; p[1] = A[j].y; p[2] = A[j].z; p[3] = A[j].w; }
        LDS_WAIT(); asm volatile("" ::: "memory");
        { const int c = lane & 7;
#pragma unroll
          for (int j = 0; j < 8; ++j) { const int n = (lane >> 3) + 8 * j; const LAS float* s = scr + (8 * c) * 65 + n;
              v4u o; o.x = pkbf(s[0 * 65], s[1 * 65]); o.y = pkbf(s[2 * 65], s[3 * 65]); o.z = pkbf(s[4 * 65], s[5 * 65]); o.w = pkbf(s[6 * 65], s[7 * 65]);
              *(GAS v4u*)(dst + (size_t)n * ldk + 8 * c) = o; } }
        LDS_WAIT(); asm volatile("" ::: "memory");
        if (hn) {
#pragma unroll
            for (int j = 0; j < 16; ++j) A[j] = B[j];
            dst = dst1; ldk = ldk1; }
    }
}
__device__ __forceinline__ void conv_pull_block(Frame& F, const float* const* kargs) {
    int tid_l = F.tid; asm volatile("" : "+v"(tid_l)); const int tid = tid_l, lane = tid & 63, wave = __builtin_amdgcn_readfirstlane(tid >> 6);
    LAS float* scr = (LAS float*)(F.lds + RING_OFF + wave * 16640);
    gu32* q = F.ctl + CW_CONVQ;
    if (tid == 0) F.MISC[12] = __hip_atomic_fetch_add(q, (unsigned)(CONV_CHUNK * NWAVES), RLX_AGENT);
    __syncthreads();
    const unsigned base = (unsigned)__builtin_amdgcn_readfirstlane((int)F.MISC[12]) + (unsigned)(CONV_CHUNK * wave);
    if (base < 2u * NIT_MOE) conv_items<true>(kargs, F.ws, scr, lane, (int)base, 1, CONV_CHUNK);
    __syncthreads();
}
__device__ __forceinline__ void conv_drain(Frame& F, const float* const* kargs, int li) {
    int tid_l = F.tid; asm volatile("" : "+v"(tid_l)); const int tid = tid_l, lane = tid & 63, wave = __builtin_amdgcn_readfirstlane(tid >> 6);
    LAS float* scr = (LAS float*)(F.lds + RING_OFF + wave * 16640);
    const int end = (li + 1) * NIT_MOE;
    const int snap = __builtin_amdgcn_readfirstlane((int)__hip_atomic_load(F.ctl + CW_CONVSNAP + 64 * li, RLX_AGENT));
    if (blockIdx.x == 0 && tid == 0) __hip_atomic_fetch_max(F.ctl + CW_CONVQ, (unsigned)end, RLX_AGENT);
    const int gw = F.vcu * NWAVES + wave, NGW = F.G * NWAVES, first = snap + gw;
    conv_items<true>(kargs, F.ws, scr, lane, first, NGW, first < end ? (end - 1 - first) / NGW + 1 : 0);
}
__device__ __forceinline__ void p0_prologue(Frame& F, const float* const* kargs) {
    int tid_l = F.tid; asm volatile("" : "+v"(tid_l)); const int tid = tid_l, lane = tid & 63, wave = __builtin_amdgcn_readfirstlane(tid >> 6); (void)tid; (void)lane; (void)wave;
    LAS float* scr = (LAS float*)(F.lds + RING_OFF + wave * 16640);
    const int gw = F.vcu * NWAVES + wave, NGW = F.G * NWAVES;
    conv_items<false>(kargs, F.ws, scr, lane, gw, NGW, gw < 2 * NIT_ST ? (2 * NIT_ST - 1 - gw) / NGW + 1 : 0);
    for (int li = 0; li < 2; ++li) { const float* wsp = KIN(4) + (size_t)li * NHEAD * CHUNK * CHUNK; bf16* dsp = (bf16*)(F.ws + WS_WE + (size_t)li * WE_STRIDE + WE_SP);
        for (int q = (F.vcu * NWAVES * 64 + tid); q < NHEAD * CHUNK * CHUNK / 4; q += F.G * NWAVES * 64) {
            const int e0 = q * 4, t = (e0 >> 7) & 127, s = e0 & 127; const f32x4 v = *(const f32x4*)(wsp + e0);
            u32x2 o; o.x = pkbf(s + 0 <= t ? v.x : 0.f, s + 1 <= t ? v.y : 0.f); o.y = pkbf(s + 2 <= t ? v.z : 0.f, s + 3 <= t ? v.w : 0.f);
            *(GAS u32x2*)(dsp + e0) = o; } }
}
__device__ __forceinline__ void rms_phase(Frame& F, const float* src, const float* gain, bf16* dst) {
    int tid_l = F.tid; asm volatile("" : "+v"(tid_l)); const int tid = tid_l, lane = tid & 63, wave = __builtin_amdgcn_readfirstlane(tid >> 6); (void)tid; (void)lane; (void)wave;
    const int gw = F.vcu * NWAVES + wave, NGW = F.G * NWAVES;
    f32x4 g[4];
#pragma unroll
    for (int j = 0; j < 4; ++j) g[j] = *(const f32x4*)(gain + 4 * lane + 256 * j);
    for (int m = gw; m < M; m += NGW) {
        const GAS f32x4* xr = (const GAS f32x4*)(src + (size_t)m * D) + lane;
        f32x4 v[4]; float s = 0.f;
#pragma unroll
        for (int j = 0; j < 4; ++j) { v[j] = xr[64 * j]; s += dot4(v[j], v[j]); }
        const float rstd = 1.0f / sqrtf(wave_sum(s) * (1.f / D) + EPS);
        GAS u32x2* o8 = (GAS u32x2*)(dst + (size_t)m * D) + lane;
#pragma unroll
        for (int j = 0; j < 4; ++j) { const f32x4 y = v[j] * rstd * g[j]; u32x2 w; w.x = pkbf(y.x, y.y); w.y = pkbf(y.z, y.w); o8[64 * j] = w; }
    }
}
constexpr int TSTR = 272;
__device__ __forceinline__ void mixer_phase(Frame& F, int li, const float* sgu_norm, const float* b_spatial, const float* pool_scale) {
    const bf16* proj = (const bf16*)(F.ws + WS_PROJ); bf16* mix = (bf16*)(F.ws + WS_MIX);
    const bf16* wsp = (const bf16*)(F.ws + WS_WE + (size_t)li * WE_STRIDE + WE_SP); const bf16* wpl = (const bf16*)(F.ws + WS_WE + (size_t)li * WE_STRIDE + WE_PL);
    int tid_l = F.tid; asm volatile("" : "+v"(tid_l)); const int tid = tid_l, lane = tid & 63, wave = __builtin_amdgcn_readfirstlane(tid >> 6); (void)tid; (void)lane; (void)wave;
    const int fr = lane & 15, fq = lane >> 4;
    LAS float* rs = (LAS float*)(F.lds + RING_OFF);
    LAS unsigned char* T = F.lds + RING_OFF + 512 + wave * (64 * TSTR);
    for (int u = F.vcu; u < 2 * (M / CHUNK); u += F.G) {
        const int chunk = u >> 1, part = u & 1, tok0 = chunk * CHUNK;
        if (part == 0) {
            const bf16* vbase = proj + (size_t)tok0 * INE + AW;
#pragma unroll 4
            for (int r = 0; r < 16; ++r) { const int row = wave * 16 + r; const v4u q = *(const GAS v4u*)(vbase + (size_t)row * INE + lane * 8);
                float s = 0.f;
#pragma unroll
                for (int k = 0; k < 4; ++k) { const float a = bf_lo(q[k]), b = bf_hi(q[k]); s += a * a + b * b; }
                s = wave_sum(s); if (lane == 0) rs[row] = 1.0f / sqrtf(s * (1.f / AW) + EPS); }
            __syncthreads();
            const int h = wave, rp = lane >> 3, cg = lane & 7;
            { const f32x4 ga = *(const f32x4*)(sgu_norm + li * AW + h * HD + cg * 8), gb = *(const f32x4*)(sgu_norm + li * AW + h * HD + cg * 8 + 4);
              const float gv[8] = {ga.x, ga.y, ga.z, ga.w, gb.x, gb.y, gb.z, gb.w};
#pragma unroll
              for (int st = 0; st < 8; ++st) { const int s = st * 16 + 2 * rp;
                  const v4u q0 = *(const GAS v4u*)(vbase + (size_t)s * INE + h * HD + cg * 8), q1 = *(const GAS v4u*)(vbase + (size_t)(s + 1) * INE + h * HD + cg * 8);
                  const float r0 = rs[s], r1 = rs[s + 1];
#pragma unroll
                  for (int k = 0; k < 4; ++k) {
                      *(LAS unsigned*)(T + (cg * 8 + 2 * k) * TSTR + s * 2) = pkbf(bf_lo(q0[k]) * r0 * gv[2 * k], bf_lo(q1[k]) * r1 * gv[2 * k]);
                      *(LAS unsigned*)(T + (cg * 8 + 2 * k + 1) * TSTR + s * 2) = pkbf(bf_hi(q0[k]) * r0 * gv[2 * k + 1], bf_hi(q1[k]) * r1 * gv[2 * k + 1]); } } }
            LDS_WAIT(); asm volatile("" ::: "memory");
            const bf16* Wh = wsp + (size_t)h * CHUNK * CHUNK; const float* bs = b_spatial + (li * NHEAD + h) * CHUNK;
#pragma unroll
            for (int ti = 0; ti < 8; ++ti) {
                constexpr int dummy = 0; (void)dummy;
                const int nks = ti / 2 + 1;
                bf16x8 bw[4];
#pragma unroll
                for (int ks = 0; ks < 4; ++ks) if (ks < nks) bw[ks] = *(const GAS bf16x8*)(Wh + (size_t)(16 * ti + fr) * CHUNK + 32 * ks + 8 * fq);
                const int t = 16 * ti + fr; const float bt = bs[t]; const size_t tok = (size_t)tok0 + t;
#pragma unroll
                for (int dj = 0; dj < 4; ++dj) {
                    f32x4 acc = (f32x4){0.f, 0.f, 0.f, 0.f};
#pragma unroll
                    for (int ks = 0; ks < 4; ++ks) if (ks < nks) { const bf16x8 a = *(const LAS bf16x8*)(T + (16 * dj + fr) * TSTR + (32 * ks + 8 * fq) * 2); acc = __builtin_amdgcn_mfma_f32_16x16x32_bf16(a, bw[ks], acc, 0, 0, 0); }
                    const int d = 16 * dj + 4 * fq;
                    const u32x2 uu = *(const GAS u32x2*)(proj + tok * INE + h * HD + d);
                    u32x2 o; o.x = pkbf(bf_lo(uu.x) * (acc[0] + bt), bf_hi(uu.x) * (acc[1] + bt)); o.y = pkbf(bf_lo(uu.y) * (acc[2] + bt), bf_hi(uu.y) * (acc[3] + bt));
                    *(GAS u32x2*)(mix + tok * D + h * HD + d) = o;
                }
            }
        } else {
            const int g = wave >> 1, rh = wave & 1, win = 2 << g;
            const int p0 = (tok0 & (SEQ - 1)) + 64 * rh;
            const size_t tokr = (size_t)tok0 + 64 * rh;
            const bf16* zb = proj + 2 * AW + g * GD + 2 * lane;
            float sx = 0.f, sy = 0.f;
#pragma unroll
            for (int j = 1; j <= 16; ++j) { const bool valid = (j <= win) && (p0 - j >= 0); const size_t row = valid ? tokr - j : tokr;
                const unsigned q = *(const GAS unsigned*)(zb + row * INE); sx += valid ? bf_lo(q) : 0.f; sy += valid ? bf_hi(q) : 0.f; }
#pragma unroll 8
            for (int i = 0; i < 64; ++i) { const bool valid = (p0 + i - win >= 0); const size_t rowo = valid ? tokr + i - win : tokr;
                const unsigned q = *(const GAS unsigned*)(zb + (tokr + i) * INE), qo = *(const GAS unsigned*)(zb + rowo * INE);
                const float zx = bf_lo(q), zy = bf_hi(q);
                sx += zx - (valid ? bf_lo(qo) : 0.f); sy += zy - (valid ? bf_hi(qo) : 0.f);
                const int cnt = (p0 + i + 1 < win) ? (p0 + i + 1) : win; const float inv = 1.0f / (float)cnt;
                *(LAS unsigned*)(T + i * TSTR + lane * 4) = pkbf(sx * inv - zx, sy * inv - zy); }
            LDS_WAIT(); asm volatile("" ::: "memory");
            const bf16* Wp = wpl + (size_t)g * GD * GD;
            bf16x8 bm[4][4];
#pragma unroll
            for (int ti = 0; ti < 4; ++ti)
#pragma unroll
                for (int ks = 0; ks < 4; ++ks) bm[ti][ks] = *(const LAS bf16x8*)(T + (16 * ti + fr) * TSTR + (32 * ks + 8 * fq) * 2);
#pragma unroll 2
            for (int dj = 0; dj < 8; ++dj) {
                bf16x8 aw[4];
#pragma unroll
                for (int ks = 0; ks < 4; ++ks) aw[ks] = *(const GAS bf16x8*)(Wp + (size_t)(16 * dj + fr) * GD + 32 * ks + 8 * fq);
                const f32x4 sc = *(const f32x4*)(pool_scale + li * BW + g * GD + 16 * dj + 4 * fq);
#pragma unroll
                for (int ti = 0; ti < 4; ++ti) {
                    f32x4 acc = (f32x4){0.f, 0.f, 0.f, 0.f};
#pragma unroll
                    for (int ks = 0; ks < 4; ++ks) acc = __builtin_amdgcn_mfma_f32_16x16x32_bf16(aw[ks], bm[ti][ks], acc, 0, 0, 0);
                    u32x2 o; o.x = pkbf(acc[0] * sc.x, acc[1] * sc.y); o.y = pkbf(acc[2] * sc.z, acc[3] * sc.w);
                    *(GAS u32x2*)(mix + (tokr + 16 * ti + fr) * D + AW + g * GD + 16 * dj + 4 * fq) = o;
                }
            }
        }
        __syncthreads();
    }
}
__device__ __forceinline__ void conv_phase(Frame& F, const float* w_dw, const float* b_dw, const float* ln_g, const float* ln_b) {
    const bf16* glu = (const bf16*)(F.ws + WS_GLU); bf16* cvo = (bf16*)(F.ws + WS_CV);
    int tid_l = F.tid; asm volatile("" : "+v"(tid_l)); const int tid = tid_l, lane = tid & 63, wave = __builtin_amdgcn_readfirstlane(tid >> 6); (void)tid; (void)lane; (void)wave;
    const int c0 = 2 * tid;
    LAS float* cv = (LAS float*)(F.lds + RING_OFF);
    f32x2 w[CONVK];
#pragma unroll
    for (int k = 0; k < CONVK; ++k) w[k] = *(const f32x2*)(w_dw + (size_t)k * D + c0);
    const f32x2 bd = *(const f32x2*)(b_dw + c0);
    for (int u = F.vcu; u < M / 16; u += F.G) {
        const int tok0 = u * 16; const bool hist = (tok0 & (SEQ - 1)) != 0;
        unsigned xin[46];
#pragma unroll
        for (int j = 0; j < 46; ++j) { const bool valid = (j >= 30) || hist; const size_t row = valid ? (size_t)(tok0 - 30 + j) : (size_t)tok0;
            const unsigned q = *(const GAS unsigned*)(glu + row * D + c0); xin[j] = valid ? q : 0u; }
        f32x2 acc[16];
#pragma unroll
        for (int i = 0; i < 16; ++i) acc[i] = bd;
#pragma unroll
        for (int j = 0; j < 46; ++j) { const f32x2 x = (f32x2){bf_lo(xin[j]), bf_hi(xin[j])};
#pragma unroll
            for (int i = 0; i < 16; ++i) if (j - i >= 0 && j - i <= 30) acc[i] += w[j - i] * x; }
#pragma unroll
        for (int i = 0; i < 16; ++i) *(LAS f32x2*)(cv + i * D + c0) = acc[i];
        __syncthreads();
#pragma unroll
        for (int rr = 0; rr < 2; ++rr) { const int row = 2 * wave + rr;
            f32x4 v[4]; float s = 0.f;
#pragma unroll
            for (int j = 0; j < 4; ++j) { v[j] = *(const LAS f32x4*)(cv + row * D + 4 * lane + 256 * j); s += (v[j].x + v[j].y) + (v[j].z + v[j].w); }
            const float mean = wave_sum(s) * (1.f / D); float s2 = 0.f;
#pragma unroll
            for (int j = 0; j < 4; ++j) { v[j] = v[j] - mean; s2 += dot4(v[j], v[j]); }
            const float rstd = 1.0f / sqrtf(wave_sum(s2) * (1.f / D) + EPS);
            GAS u32x2* o8 = (GAS u32x2*)(cvo + (size_t)(tok0 + row) * D) + lane;
#pragma unroll
            for (int j = 0; j < 4; ++j) { const f32x4 gg = *(const f32x4*)(ln_g + 4 * lane + 256 * j), bb = *(const f32x4*)(ln_b + 4 * lane + 256 * j);
                const f32x4 y = v[j] * rstd * gg + bb; u32x2 o; o.x = pkbf(silu_f(y.x), silu_f(y.y)); o.y = pkbf(silu_f(y.z), silu_f(y.w)); o8[64 * j] = o; } }
        __syncthreads();
    }
}
__device__ __forceinline__ void router_phase(Frame& F, const float* src, const float* gain, const float* w_router, bf16* dst) {
    int tid_l = F.tid; asm volatile("" : "+v"(tid_l)); const int tid = tid_l, lane = tid & 63, wave = __builtin_amdgcn_readfirstlane(tid >> 6); (void)tid; (void)lane; (void)wave;
    LAS float* wrT = (LAS float*)(F.lds + RING_OFF);
    LAS unsigned* lc = (LAS unsigned*)(F.lds + RING_OFF + 32768);
    for (int c = tid; c < D; c += NWAVES * 64) { const f32x4 a = *(const f32x4*)(w_router + (size_t)c * NEXP), b = *(const f32x4*)(w_router + (size_t)c * NEXP + 4);
        wrT[0 * D + c] = a.x; wrT[1 * D + c] = a.y; wrT[2 * D + c] = a.z; wrT[3 * D + c] = a.w; wrT[4 * D + c] = b.x; wrT[5 * D + c] = b.y; wrT[6 * D + c] = b.z; wrT[7 * D + c] = b.w; }
    f32x4 g[4];
#pragma unroll
    for (int j = 0; j < 4; ++j) g[j] = *(const f32x4*)(gain + 4 * lane + 256 * j);
    i32x4* tokinfo = (i32x4*)(F.ws + WS_TOKINFO); int* cnttab = (int*)(F.ws + WS_CNTTAB);
    for (int u = F.vcu; u < M / 64; u += F.G) {
        if (tid < NEXP) lc[tid] = 0u;
        __syncthreads();
        for (int q = 0; q < 8; ++q) { const int m = u * 64 + wave * 8 + q;
            const GAS f32x4* xr = (const GAS f32x4*)(src + (size_t)m * D) + lane;
            f32x4 v[4]; float s = 0.f;
#pragma unroll
            for (int j = 0; j < 4; ++j) { v[j] = xr[64 * j]; s += dot4(v[j], v[j]); }
            const float rstd = 1.0f / sqrtf(wave_sum(s) * (1.f / D) + EPS);
            GAS u32x2* o8 = (GAS u32x2*)(dst + (size_t)m * D) + lane;
#pragma unroll
            for (int j = 0; j < 4; ++j) { v[j] = v[j] * rstd * g[j]; u32x2 w; w.x = pkbf(v[j].x, v[j].y); w.y = pkbf(v[j].z, v[j].w); o8[64 * j] = w; }
            float lg[NEXP];
#pragma unroll
            for (int e = 0; e < NEXP; ++e) { float p = 0.f;
#pragma unroll
                for (int j = 0; j < 4; ++j) p += dot4(v[j], *(const LAS f32x4*)(wrT + e * D + 4 * lane + 256 * j));
                lg[e] = wave_sum(p); }
            int i1 = 0; float l1 = lg[0];
#pragma unroll
            for (int e = 1; e < NEXP; ++e) if (lg[e] > l1) { l1 = lg[e]; i1 = e; }
            int i2 = -1; float l2 = -INFINITY;
#pragma unroll
            for (int e = 0; e < NEXP; ++e) if (e != i1 && lg[e] > l2) { l2 = lg[e]; i2 = e; }
            const float g1 = 1.0f / (1.0f + __expf(l2 - l1)), g2 = 1.0f - g1;
            if (lane == 0) { tokinfo[m] = (i32x4){i1, i2, (int)__float_as_uint(g1), (int)__float_as_uint(g2)};
                __hip_atomic_fetch_add(&lc[i1], 1u, __ATOMIC_RELAXED, __HIP_MEMORY_SCOPE_WORKGROUP); __hip_atomic_fetch_add(&lc[i2], 1u, __ATOMIC_RELAXED, __HIP_MEMORY_SCOPE_WORKGROUP); }
        }
        __syncthreads();
        if (tid < NEXP) cnttab[u * NEXP + tid] = (int)lc[tid];
    }
}
__device__ __forceinline__ void scatter_phase(Frame& F, gu32* cnt) {
    int tid_l = F.tid; asm volatile("" : "+v"(tid_l)); const int tid = tid_l, lane = tid & 63, wave = __builtin_amdgcn_readfirstlane(tid >> 6); (void)tid; (void)lane; (void)wave;
    const bf16* hn = (const bf16*)(F.ws + WS_HN); bf16* hp = (bf16*)(F.ws + WS_HP);
    const i32x4* tokinfo = (const i32x4*)(F.ws + WS_TOKINFO); i32x2* tokslot = (i32x2*)(F.ws + WS_TOKSLOT); float* slotgate = (float*)(F.ws + WS_SLOTGATE);
    const int* cnttab = (const int*)(F.ws + WS_CNTTAB);
    LAS int* tot = (LAS int*)(F.lds + RING_OFF);
    LAS int* pre = tot + 8;
    LAS int* pbase = tot + 16;
    LAS int* le = tot + 32;
    LAS int* sl = tot + 160;
    for (int u = F.vcu; u < M / 64; u += F.G) {
        const int tok0 = u * 64;
        if (tid < 16) tot[tid] = 0;
        __syncthreads();
        { const int e = tid & 7, part = tid >> 3; int s_all = 0, s_pre = 0;
#pragma unroll
          for (int k = 0; k < (M / 64) / 64; ++k) { const int uu = part * ((M / 64) / 64) + k; const int c = cnttab[uu * NEXP + e]; s_all += c; s_pre += (uu < u) ? c : 0; }
          __hip_atomic_fetch_add(&tot[e], s_all, __ATOMIC_RELAXED, __HIP_MEMORY_SCOPE_WORKGROUP); __hip_atomic_fetch_add(&pre[e], s_pre, __ATOMIC_RELAXED, __HIP_MEMORY_SCOPE_WORKGROUP); }
        i32x4 info = (i32x4){0, 0, 0, 0};
        if (tid < 64) { info = tokinfo[tok0 + tid]; le[2 * tid] = info.x; le[2 * tid + 1] = info.y; }
        __syncthreads();
        if (tid == 0) { int acc = 0;
#pragma unroll
            for (int e = 0; e < NEXP; ++e) { const int t = tot[e]; pbase[e] = acc * 256 + pre[e]; acc += (t + 255) >> 8; if (u == 0) __hip_atomic_store(cnt + 64 * e, (unsigned)t, RLX_AGENT); } }
        __syncthreads();
        if (tid < 64) { int r1 = 0, r2 = 0;
            for (int t = 0; t < tid; ++t) { const int a = le[2 * t], b = le[2 * t + 1]; r1 += (a == info.x) + (b == info.x); r2 += (a == info.y) + (b == info.y); }
            const int s1 = pbase[info.x] + r1, s2 = pbase[info.y] + r2;
            tokslot[tok0 + tid] = (i32x2){s1, s2}; slotgate[s1] = __uint_as_float((unsigned)info.z); slotgate[s2] = __uint_as_float((unsigned)info.w);
            sl[2 * tid] = s1; sl[2 * tid + 1] = s2; }
        __syncthreads();
#pragma unroll 4
        for (int q = 0; q < 8; ++q) { const int tl = wave * 8 + q; const int s1 = sl[2 * tl], s2 = sl[2 * tl + 1];
            const GAS v4u* src = (const GAS v4u*)(hn + (size_t)(tok0 + tl) * D) + lane; const v4u a = src[0], b = src[64];
            GAS v4u* d1 = (GAS v4u*)(hp + (size_t)s1 * D) + lane; GAS v4u* d2 = (GAS v4u*)(hp + (size_t)s2 * D) + lane;
            d1[0] = a; d1[64] = b; d2[0] = a; d2[64] = b; }
        __syncthreads();
    }
}
__device__ __forceinline__ f32x4 y_frag(const bf16* y, const float* part, const float* slotgate, int slot, int j, int lane) {
    if ((slot >> 8) >= DNX_FULL) {
        const float* p = part + ((size_t)(((slot >> 8) - DNX_FULL) * (D / 256) + j) * DNX_NS) * 65536 + (size_t)(slot & 255) * 256 + 4 * lane;
        f32x4 s = *(const GAS f32x4*)p;
#pragma unroll
        for (int sl = 1; sl < DNX_NS; ++sl) s += *(const GAS f32x4*)(p + (size_t)sl * 65536);
        return s * slotgate[slot];
    }
    const u32x2 a = *((const GAS u32x2*)(y + (size_t)slot * D) + lane + 64 * j);
    return (f32x4){bf_lo(a.x), bf_hi(a.x), bf_lo(a.y), bf_hi(a.y)};
}
__device__ __forceinline__ void combine_phase(Frame& F, float* h, const float* gain, bf16* dst, float* fout) {
    int tid_l = F.tid; asm volatile("" : "+v"(tid_l)); const int tid = tid_l, lane = tid & 63, wave = __builtin_amdgcn_readfirstlane(tid >> 6); (void)tid; (void)lane; (void)wave;
    const int gw = F.vcu * NWAVES + wave, NGW = F.G * NWAVES;
    const bf16* y = (const bf16*)(F.ws + WS_Y); const i32x2* tokslot = (const i32x2*)(F.ws + WS_TOKSLOT);
    const float* part = (const float*)(F.ws + WS_PART); const float* slotgate = (const float*)(F.ws + WS_SLOTGATE);
    f32x4 g[4];
#pragma unroll
    for (int j = 0; j < 4; ++j) g[j] = *(const f32x4*)(gain + 4 * lane + 256 * j);
    for (int m = gw; m < M; m += NGW) {
        const i32x2 ss = tokslot[m]; const int s1 = __builtin_amdgcn_readfirstlane(ss.x), s2 = __builtin_amdgcn_readfirstlane(ss.y);
        GAS f32x4* xr = (GAS f32x4*)(h + (size_t)m * D) + lane;
        f32x4 v[4]; float s = 0.f;
#pragma unroll
        for (int j = 0; j < 4; ++j) { v[j] = xr[64 * j] + y_frag(y, part, slotgate, s1, j, lane) + y_frag(y, part, slotgate, s2, j, lane); s += dot4(v[j], v[j]); }
        const float rstd = 1.0f / sqrtf(wave_sum(s) * (1.f / D) + EPS);
        if (fout) { GAS f32x4* o = (GAS f32x4*)(fout + (size_t)m * D) + lane;
#pragma unroll
            for (int j = 0; j < 4; ++j) o[64 * j] = v[j] * rstd * g[j]; }
        else { GAS u32x2* o8 = (GAS u32x2*)(dst + (size_t)m * D) + lane;
#pragma unroll
            for (int j = 0; j < 4; ++j) { xr[64 * j] = v[j]; const f32x4 yv = v[j] * rstd * g[j]; u32x2 w; w.x = pkbf(yv.x, yv.y); w.y = pkbf(yv.z, yv.w); o8[64 * j] = w; } }
    }
}

struct Args { const float* in[28]; float* out; unsigned char* ws; int ph_lo, ph_hi; };
#define PG8_ALIGN true
#define PG8_SP2 true
__global__ void __launch_bounds__(NWAVES * 64, 2) trunk_fwd(Args args) {
    extern __shared__ __attribute__((aligned(16))) unsigned char lds[];
    Frame F;
    F.lds = (LAS unsigned char*)lds;
    F.MISC = (volatile LAS unsigned*)(F.lds + MISC_OFF);
    F.tid = threadIdx.x; F.lane = F.tid & 63; F.wave = __builtin_amdgcn_readfirstlane(F.tid >> 6);
    F.G = gridDim.x; { const int bx = blockIdx.x; F.vcu = (F.G % 8 == 0) ? (bx % 8) * (F.G / 8) + bx / 8 : bx; }
    F.ws = args.ws; F.out = args.out; F.in = nullptr;
    F.ctl = (gu32*)(args.ws + WS_CTL);
    for (int u = F.tid; u < (LDS_BYTES - LDSCTL_OFF) / 4; u += NWAVES * 64) ((LAS unsigned*)(F.lds + LDSCTL_OFF))[u] = 0u;
    __syncthreads();
    XcdBarrier bar = xcd_barrier_post((unsigned*)(F.ctl + CW_BAR), F.MISC + 8);
    const float* const* kargs = (const float* const*)__builtin_amdgcn_kernarg_segment_ptr();
#define INP(k) ({ const float* const* p_ = kargs; asm volatile("" : "+s"(p_)); p_[k]; })
    const int lo = args.ph_lo, hi = args.ph_hi;
    int ph = 0;
#ifndef PHMASK
#define PHMASK 0xffff
#endif
#define EN(k) (((PHMASK) >> (k)) & 1)
#define RUN() (lo <= ph && ph < hi)
#ifndef CONV_QUOTA
#define CONV_QUOTA 1
#endif
#define TAIL_PULL(nwg_) do { const int nw_ = (nwg_), c_ = (int)blockIdx.x; const int mine_ = c_ < nw_ ? (nw_ - 1 - c_) / F.G + 1 : 0, most_ = (nw_ + F.G - 1) / F.G; \
        if (mine_ < most_) conv_pull_block(F, kargs); } while (0)
#define SEAM() do { if (lo <= ph && ph + 1 < hi) { xcd_barrier(bar); if (PROBE_DUP & 16) { xcd_barrier(bar); xcd_barrier(bar); } } ++ph; } while (0)
    unsigned char* const ws = args.ws;
    float* const H = (float*)(ws + WS_H); bf16* const HN = (bf16*)(ws + WS_HN);

#ifndef PROBE_DUP
#define PROBE_DUP 0
#endif
    if (EN(0) && RUN()) { p0_prologue(F, kargs); if (PROBE_DUP & 1) p0_prologue(F, kargs); rms_phase(F, INP(0), INP(1), HN); }
    SEAM();

#pragma unroll 1
    for (int li = 0; li < 2; ++li) {
        unsigned char* const we = ws + WS_WE + (size_t)li * WE_STRIDE; unsigned char* const wo = ws + WS_WO + (size_t)li * WO_STRIDE;
        if (EN(1) && RUN()) { pg8::Gemm g{HN, (const bf16*)(we + WE_IN), M, INE, D, D}; pg8::StaticOrder S; S.init(M, INE, F.G, (int)blockIdx.x);
            pg8::EpiGeluSplit E{(bf16*)(ws + WS_PROJ), INE, 4};
            pg8::gemm_phase<pg8::EpiGeluSplit, pg8::StaticOrder, PG8_ALIGN, PG8_SP2>(F.lds + RING_OFF, g, S, E);
            TAIL_PULL(S.nwg); }
        SEAM();
        if (EN(2) && RUN()) { mixer_phase(F, li, INP(3), INP(5), INP(7)); if (PROBE_DUP & 2) mixer_phase(F, li, INP(3), INP(5), INP(7)); }
        SEAM();
        if (EN(3) && RUN()) { pg8::Gemm g{(const bf16*)(ws + WS_MIX), (const bf16*)(we + WE_OUT), M, D, D, D}; pg8::StaticOrder S; S.init(M, D, F.G, (int)blockIdx.x);
            pg8::EpiRes E{li == 0 ? INP(0) : (const float*)H, H, D, nullptr};
            pg8::gemm_phase<pg8::EpiRes, pg8::StaticOrder, PG8_ALIGN, PG8_SP2>(F.lds + RING_OFF, g, S, E); }
        SEAM();
        if (EN(4) && RUN()) { rms_phase(F, H, INP(9) + li * D, HN); if (PROBE_DUP & 4) rms_phase(F, H, INP(9) + li * D, HN); }
        SEAM();
        if (EN(5) && RUN()) { pg8::Gemm g{HN, (const bf16*)(we + WE_GU), M, 2 * FFD, D, D}; pg8::StaticOrder S; S.init(M, 2 * FFD, F.G, (int)blockIdx.x);
            pg8::EpiGlu<0> E{(bf16*)(ws + WS_ACT), FFD, nullptr, nullptr};
            pg8::gemm_phase<pg8::EpiGlu<0>, pg8::StaticOrder, PG8_ALIGN, PG8_SP2>(F.lds + RING_OFF, g, S, E);
            if (PROBE_DUP & 32) { __syncthreads(); pg8::gemm_phase<pg8::EpiGlu<0>, pg8::StaticOrder, PG8_ALIGN, PG8_SP2>(F.lds + RING_OFF, g, S, E); }
            TAIL_PULL(S.nwg);
            if (PROBE_DUP & 64) { __syncthreads(); pg8::SameTileOrder S2; S2.nwg = S.nwg; S2.G = F.G; S2.c = (int)blockIdx.x; pg8::EpiGlu<0> E2{(bf16*)(ws + WS_Y), FFD, nullptr, nullptr};
                pg8::gemm_phase<pg8::EpiGlu<0>, pg8::SameTileOrder, PG8_ALIGN, PG8_SP2>(F.lds + RING_OFF, g, S2, E2); } }
        SEAM();
        if (EN(6) && RUN()) { pg8::Gemm g{(const bf16*)(ws + WS_ACT), (const bf16*)(we + WE_DN), M, D, FFD, FFD}; pg8::StaticOrder S; S.init(M, D, F.G, (int)blockIdx.x);
            pg8::EpiRes E{H, H, D, nullptr};
            pg8::gemm_phase<pg8::EpiRes, pg8::StaticOrder, PG8_ALIGN, PG8_SP2>(F.lds + RING_OFF, g, S, E); }
        SEAM();
        if (EN(7) && RUN()) rms_phase(F, H, INP(13) + li * D, HN);
        SEAM();
        if (EN(8) && RUN()) { pg8::Gemm g{HN, (const bf16*)(wo + WO_PW1), M, 2 * D, D, D}; pg8::StaticOrder S; S.init(M, 2 * D, F.G, (int)blockIdx.x);
            pg8::EpiGlu<1> E{(bf16*)(ws + WS_GLU), D, INP(15) + li * 2 * D, INP(15) + li * 2 * D + D};
            pg8::gemm_phase<pg8::EpiGlu<1>, pg8::StaticOrder, PG8_ALIGN, PG8_SP2>(F.lds + RING_OFF, g, S, E); }
        SEAM();
        if (EN(9) && RUN() && (PROBE_DUP & 8)) conv_phase(F, INP(16) + (size_t)li * CONVK * D, INP(17) + li * D, INP(18) + li * D, INP(19) + li * D);
        if (EN(9) && RUN()) conv_phase(F, INP(16) + (size_t)li * CONVK * D, INP(17) + li * D, INP(18) + li * D, INP(19) + li * D);
        SEAM();
        if (EN(10) && RUN()) { pg8::Gemm g{(const bf16*)(ws + WS_CV), (const bf16*)(wo + WO_PW2), M, D, D, D}; pg8::StaticOrder S; S.init(M, D, F.G, (int)blockIdx.x);
            pg8::EpiRes E{H, H, D, INP(21) + li * D};
            pg8::gemm_phase<pg8::EpiRes, pg8::StaticOrder, PG8_ALIGN, PG8_SP2>(F.lds + RING_OFF, g, S, E); }
        SEAM();
        gu32* const cnt = F.ctl + CW_MOE + li * 1024;
        if (EN(11) && RUN() && blockIdx.x == 0 && threadIdx.x == 0) __hip_atomic_store(F.ctl + CW_CONVSNAP + 64 * li, __hip_atomic_load(F.ctl + CW_CONVQ, RLX_AGENT), RLX_AGENT);
        if (EN(11) && RUN()) router_phase(F, H, INP(22) + li * D, INP(23) + (size_t)li * D * NEXP, HN);
        SEAM();
        if (EN(12) && RUN()) { conv_drain(F, kargs, li); __syncthreads(); scatter_phase(F, cnt); }
        SEAM();
        if (EN(13) && RUN()) { pg8::GroupedOrder S; { int acc = 0; S.ts[0] = 0;
#pragma unroll
                for (int e = 0; e < NEXP; ++e) { const int c = __builtin_amdgcn_readfirstlane((int)__hip_atomic_load(cnt + 64 * e, RLX_AGENT)); acc += (c + 255) >> 8; S.ts[e + 1] = acc; }
                S.nM = acc; S.nN = 2 * FFX / 256; S.nwg = acc * S.nN; S.G = F.G; S.c = (int)blockIdx.x; }
            pg8::Gemm g{(const bf16*)(ws + WS_HP), (const bf16*)(wo + WO_GUX), MSLOT, 2 * FFX, D, D};
            pg8::EpiGlu<0> E{(bf16*)(ws + WS_ACTX), FFX, nullptr, nullptr};
            pg8::gemm_phase<pg8::EpiGlu<0>, pg8::GroupedOrder, PG8_ALIGN, PG8_SP2>(F.lds + RING_OFF, g, S, E);
            TAIL_PULL(S.nwg); }
        SEAM();
        if (EN(14) && RUN()) { int tsv[9]; int acc = 0; tsv[0] = 0;
#pragma unroll
            for (int e = 0; e < NEXP; ++e) { const int c = __builtin_amdgcn_readfirstlane((int)__hip_atomic_load(cnt + 64 * e, RLX_AGENT)); acc += (c + 255) >> 8; tsv[e + 1] = acc; }
            const int nfull = acc < DNX_FULL ? acc : DNX_FULL;
            { pg8::GroupedOrder S;
#pragma unroll
              for (int e = 0; e < 9; ++e) S.ts[e] = tsv[e];
              S.nM = nfull; S.nN = D / 256; S.nwg = nfull * S.nN; S.G = F.G; S.c = (int)blockIdx.x;
              pg8::Gemm g{(const bf16*)(ws + WS_ACTX), (const bf16*)(wo + WO_DNX), MSLOT, D, FFX, FFX};
              pg8::EpiScale E{(bf16*)(ws + WS_Y), D, (const float*)(ws + WS_SLOTGATE)};
              pg8::gemm_phase<pg8::EpiScale, pg8::GroupedOrder, PG8_ALIGN, PG8_SP2>(F.lds + RING_OFF, g, S, E); }
            __syncthreads();
            { pg8::SplitOrder S;
#pragma unroll
              for (int e = 0; e < 9; ++e) S.ts[e] = tsv[e];
              S.pm0 = DNX_FULL; S.R = acc - nfull; S.nN = D / 256; S.NS = DNX_NS; S.KS = DNX_KS; S.nwg = S.R * S.nN * DNX_NS; S.G = F.G; S.c = (int)blockIdx.x;
              pg8::Gemm g{(const bf16*)(ws + WS_ACTX), (const bf16*)(wo + WO_DNX), MSLOT, D, DNX_KS, FFX};
              pg8::EpiPart E{(float*)(ws + WS_PART), DNX_FULL, D / 256, DNX_NS, DNX_KS};
              pg8::gemm_phase<pg8::EpiPart, pg8::SplitOrder, PG8_ALIGN, PG8_SP2>(F.lds + RING_OFF, g, S, E); } }
        SEAM();
        if (EN(15) && RUN()) combine_phase(F, H, li == 0 ? INP(1) + D : INP(27), HN, li == 0 ? nullptr : args.out);
        SEAM();
    }
#undef RUN
#undef SEAM
}

extern "C" void kernel_launch(void* const* d_in, const int* in_sizes, int n_in, void* d_out, int out_size, void* d_ws, size_t ws_size, hipStream_t stream) {
    static int grid = 0;
    if (grid == 0) {
        if (n_in != 28 || in_sizes[0] != M * D || out_size != M * D || ws_size < WS_END) { fprintf(stderr, "kernel_launch: shape/workspace mismatch (n_in %d, in0 %d, out %d, ws %zu, need %zu); nothing launched\n", n_in, n_in > 0 ? in_sizes[0] : -1, out_size, ws_size, (size_t)WS_END); grid = -1; return; }
        int dev = 0, cus = 0, per_cu = 0;
        if (hipGetDevice(&dev) != hipSuccess || hipDeviceGetAttribute(&cus, hipDeviceAttributeMultiprocessorCount, dev) != hipSuccess) { grid = -1; return; }
        if (hipFuncSetAttribute((const void*)trunk_fwd, hipFuncAttributeMaxDynamicSharedMemorySize, LDS_BYTES) != hipSuccess) { fprintf(stderr, "kernel_launch: hipFuncSetAttribute failed\n"); grid = -1; return; }
        if (hipOccupancyMaxActiveBlocksPerMultiprocessor(&per_cu, (const void*)trunk_fwd, NWAVES * 64, LDS_BYTES) != hipSuccess || per_cu < 1)
            fprintf(stderr, "kernel_launch: note: occupancy query reports %d workgroups per CU\n", per_cu);
        (void)hipGetLastError();
        grid = cus;
    }
    if (grid < 0) return;
    if (hipMemsetAsync((char*)d_ws + WS_CTL, 0, CTL_ZERO_BYTES, stream) != hipSuccess) { fprintf(stderr, "kernel_launch: hipMemsetAsync failed\n"); return; }
    Args a{};
    for (int i = 0; i < 28; ++i) a.in[i] = (const float*)d_in[i];
    a.out = (float*)d_out; a.ws = (unsigned char*)d_ws;
#if MK_PER_PHASE
    for (int p = 0; p < NPH; ++p) { a.ph_lo = p; a.ph_hi = p + 1; hipLaunchKernelGGL(trunk_fwd, dim3(grid), dim3(NWAVES * 64), LDS_BYTES, stream, a); }
#else
    a.ph_lo = 0; a.ph_hi = NPH;
    hipLaunchKernelGGL(trunk_fwd, dim3(grid), dim3(NWAVES * 64), LDS_BYTES, stream, a);
#endif
    const hipError_t le = hipPeekAtLastError();
    if (le != hipSuccess) fprintf(stderr, "kernel_launch: launch failed: %s\n", hipGetErrorName(le));
}
```

```cpp
#include <hip/hip_runtime.h>
#include <cstdio>
#include <cstdint>
#include <cmath>
#ifndef MK_PER_PHASE
#define MK_PER_PHASE 0
#endif
namespace pg8 {
#define PG8_LAS __attribute__((address_space(3)))
typedef unsigned short bf16_t;
typedef short bf16x8 __attribute__((ext_vector_type(8)));
typedef float f32x4 __attribute__((ext_vector_type(4)));
typedef unsigned u32x4 __attribute__((ext_vector_type(4)));
constexpr int BM = 256, BK = 64, HALF = 128, HTB = HALF * BK * 2  , STAGE_BYTES = 8 * HTB, NXCD = 8, WGM = 8;

__host__ __device__ __forceinline__ int lds_byte(int r, int c) { const int st = (r >> 4) * 2 + (c >> 5), rr = r & 15, cc = c & 31, ob = rr * 64 + cc * 2; return st * 1024 + (ob ^ (((ob >> 9) & 1) << 5)); }
__host__ __device__ __forceinline__ void stage_rc(int b, int& R, int& C) { const int st = b / 1024, sb = b % 1024, swz = sb ^ (((sb >> 9) & 1) << 5); R = (st >> 1) * 16 + swz / 64; C = (st & 1) * 32 + (swz % 64) / 2; }
__host__ __device__ __forceinline__ int perm32(int rho) { const int n = rho >> 4, i = rho & 15; return 8 * (i >> 2) + 4 * n + (i & 3); }

struct Unit { int pm, pn, pb, koff; };
struct Gemm { const bf16_t* A; const bf16_t* Bt; int M, N, K, ld; };

struct StaticOrder {
    int nM, nN, nwg, G, c;
    __host__ __device__ void init(int M, int N, int G_, int c_) { nM = M / BM; nN = N / BM; nwg = nM * nN; G = G_; c = c_; }
    __host__ __device__ bool next(int i, Unit& u) const {
        const long L = (long)i * G + c; if (L >= nwg) return false;
        int wgid = (int)L; { const int q = nwg / NXCD, r = nwg % NXCD, xcd = wgid % NXCD, off = wgid / NXCD; wgid = (xcd < r ? xcd * (q + 1) : r * (q + 1) + (xcd - r) * q) + off; }
        const int nig = WGM * nN, gid = wgid / nig, fm = gid * WGM, gsz = (nM - fm) < WGM ? (nM - fm) : WGM;
        u.pm = fm + ((wgid % nig) % gsz); u.pn = (wgid % nig) / gsz; u.pb = u.pn; u.koff = 0; return true;
    }
    __device__ __forceinline__ void a_ready(const Unit&) const {}
    __device__ __forceinline__ void done(const Unit&) const {}
};


struct GroupedOrder {
    int nM, nN, nwg, G, c; int ts[9];
    __device__ __forceinline__ bool next(int i, Unit& u) const {
        const long L = (long)i * G + c; if (L >= nwg) return false;
        int wgid = (int)L; { const int q = nwg / NXCD, r = nwg % NXCD, xcd = wgid % NXCD, off = wgid / NXCD; wgid = (xcd < r ? xcd * (q + 1) : r * (q + 1) + (xcd - r) * q) + off; }
        const int nig = WGM * nN, gid = wgid / nig, fm = gid * WGM, gsz = (nM - fm) < WGM ? (nM - fm) : WGM;
        u.pm = fm + ((wgid % nig) % gsz); u.pn = (wgid % nig) / gsz;
        int e = 0;
#pragma unroll
        for (int j = 1; j < 8; ++j) e += (u.pm >= ts[j]) ? 1 : 0;
        u.pb = e * nN + u.pn; u.koff = 0; return true;
    }
    __device__ __forceinline__ void a_ready(const Unit&) const {}
    __device__ __forceinline__ void done(const Unit&) const {}
};
struct SameTileOrder {
    int nwg, G, c;
    __device__ __forceinline__ bool next(int i, Unit& u) const { const long L = (long)i * G + c; if (L >= nwg) return false; u.pm = 0; u.pn = 0; u.pb = 0; u.koff = 0; return true; }
    __device__ __forceinline__ void a_ready(const Unit&) const {}
    __device__ __forceinline__ void done(const Unit&) const {}
};
struct SplitOrder {
    int pm0, R, nN, NS, KS, nwg, G, c; int ts[9];
    __device__ __forceinline__ bool next(int i, Unit& u) const {
        const long L = (long)i * G + c; if (L >= nwg) return false;
        const int l = (int)L, s = l % NS, q = l / NS;
        u.pn = q % nN; u.pm = pm0 + q / nN; u.koff = s * KS;
        int e = 0;
#pragma unroll
        for (int j = 1; j < 8; ++j) e += (u.pm >= ts[j]) ? 1 : 0;
        u.pb = e * nN + u.pn; return true;
    }
    __device__ __forceinline__ void a_ready(const Unit&) const {}
    __device__ __forceinline__ void done(const Unit&) const {}
};

__device__ __forceinline__ unsigned cvt_pk_bf16(float lo, float hi) { unsigned r; asm volatile("v_cvt_pk_bf16_f32 %0, %1, %2" : "=v"(r) : "v"(lo), "v"(hi)); return r; }
__device__ __forceinline__ float fast_sigmoid(float x) { return __builtin_amdgcn_rcpf(1.0f + __builtin_amdgcn_exp2f(x * -1.4426950408889634f)); }
__device__ __forceinline__ float gelu_tanh(float x) {
    const float t = x * (1.0f + 0.044715f * x * x);
    return x * __builtin_amdgcn_rcpf(1.0f + __builtin_amdgcn_exp2f(t * -2.3022081986f));
}
__device__ __forceinline__ f32x4 gelu4(f32x4 v) { return (f32x4){gelu_tanh(v[0]), gelu_tanh(v[1]), gelu_tanh(v[2]), gelu_tanh(v[3])}; }

struct EpiGeluSplit {
    static constexpr bool PERM = true, AFTER_DRAIN = false;
    bf16_t* O; int ldc; int gelu_tiles;
    __device__ __forceinline__ void operator()(const f32x4 (&acc)[2][2][4][2], const Unit& u, int wr, int wc, int fr, int fq) const {
        const int row0 = u.pm * BM + wr * 64 + fr, col0 = u.pn * BM + wc * 32 + 8 * fq;
        const bool act = u.pn < gelu_tiles;
#pragma unroll
        for (int ai = 0; ai < 2; ++ai)
#pragma unroll
            for (int m = 0; m < 4; ++m) { bf16_t* rowp = O + (size_t)(row0 + ai * HALF + m * 16) * ldc + col0;
#pragma unroll
                for (int bj = 0; bj < 2; ++bj) { f32x4 v0 = acc[ai][bj][m][0], v1 = acc[ai][bj][m][1];
                    if (act) { v0 = gelu4(v0); v1 = gelu4(v1); }
                    u32x4 w; w.x = cvt_pk_bf16(v0[0], v0[1]); w.y = cvt_pk_bf16(v0[2], v0[3]); w.z = cvt_pk_bf16(v1[0], v1[1]); w.w = cvt_pk_bf16(v1[2], v1[3]);
                    *(u32x4*)(rowp + bj * HALF) = w; } }
    }
};
struct EpiRes {
    static constexpr bool PERM = false, AFTER_DRAIN = false;
    const float* base; float* out; int ldc; const float* bias;
    __device__ __forceinline__ void operator()(const f32x4 (&acc)[2][2][4][2], const Unit& u, int wr, int wc, int fr, int fq) const {
        const int row0 = u.pm * BM + wr * 64 + fr, col0 = u.pn * BM + wc * 32 + 4 * fq;
        f32x4 bv[2][2];
#pragma unroll
        for (int bj = 0; bj < 2; ++bj)
#pragma unroll
            for (int n = 0; n < 2; ++n) bv[bj][n] = bias ? *(const f32x4*)(bias + col0 + bj * HALF + n * 16) : (f32x4){0.f, 0.f, 0.f, 0.f};
#pragma unroll
        for (int ai = 0; ai < 2; ++ai) {
            f32x4 pre[4][2][2];
#pragma unroll
            for (int m = 0; m < 4; ++m) { const size_t off = (size_t)(row0 + ai * HALF + m * 16) * ldc + col0;
#pragma unroll
                for (int bj = 0; bj < 2; ++bj)
#pragma unroll
                    for (int n = 0; n < 2; ++n) pre[m][bj][n] = *(const f32x4*)(base + off + bj * HALF + n * 16); }
#pragma unroll
            for (int m = 0; m < 4; ++m) { const size_t off = (size_t)(row0 + ai * HALF + m * 16) * ldc + col0;
#pragma unroll
                for (int bj = 0; bj < 2; ++bj)
#pragma unroll
                    for (int n = 0; n < 2; ++n) *(f32x4*)(out + off + bj * HALF + n * 16) = pre[m][bj][n] + acc[ai][bj][m][n] + bv[bj][n]; }
        }
    }
};
template <int MODE> struct EpiGlu {
    static constexpr bool PERM = true, AFTER_DRAIN = false;
    bf16_t* O; int ldo; const float* bias0; const float* bias1;
    __device__ __forceinline__ void operator()(const f32x4 (&acc)[2][2][4][2], const Unit& u, int wr, int wc, int fr, int fq) const {
        const int row0 = u.pm * BM + wr * 64 + fr, ocol = u.pn * HALF + wc * 32 + 8 * fq;
        f32x4 b0[2], b1[2];
#pragma unroll
        for (int n = 0; n < 2; ++n) { b0[n] = (MODE == 1) ? *(const f32x4*)(bias0 + ocol + 4 * n) : (f32x4){0.f, 0.f, 0.f, 0.f}; b1[n] = (MODE == 1) ? *(const f32x4*)(bias1 + ocol + 4 * n) : (f32x4){0.f, 0.f, 0.f, 0.f}; }
#pragma unroll
        for (int ai = 0; ai < 2; ++ai)
#pragma unroll
            for (int m = 0; m < 4; ++m) { bf16_t* rowp = O + (size_t)(row0 + ai * HALF + m * 16) * ldo + ocol;
                f32x4 r[2];
#pragma unroll
                for (int n = 0; n < 2; ++n) { const f32x4 a = acc[ai][0][m][n] + b0[n], b = acc[ai][1][m][n] + b1[n];
#pragma unroll
                    for (int i = 0; i < 4; ++i) r[n][i] = (MODE == 0) ? (a[i] * fast_sigmoid(a[i]) * b[i]) : (a[i] * fast_sigmoid(b[i])); }
                u32x4 w; w.x = cvt_pk_bf16(r[0][0], r[0][1]); w.y = cvt_pk_bf16(r[0][2], r[0][3]); w.z = cvt_pk_bf16(r[1][0], r[1][1]); w.w = cvt_pk_bf16(r[1][2], r[1][3]);
                *(u32x4*)rowp = w; }
    }
};
struct EpiPart {
    static constexpr bool PERM = false, AFTER_DRAIN = false;
    float* P; int pm0, nN, NS, KS;
    __device__ __forceinline__ void operator()(const f32x4 (&acc)[2][2][4][2], const Unit& u, int wr, int wc, int fr, int fq) const {
        float* tile = P + ((size_t)((u.pm - pm0) * nN + u.pn) * NS + u.koff / KS) * (BM * BM);
        const int row0 = wr * 64 + fr, col0 = wc * 32 + 4 * fq;
#pragma unroll
        for (int ai = 0; ai < 2; ++ai)
#pragma unroll
            for (int m = 0; m < 4; ++m) { float* rowp = tile + (size_t)(row0 + ai * HALF + m * 16) * BM + col0;
#pragma unroll
                for (int bj = 0; bj < 2; ++bj)
#pragma unroll
                    for (int n = 0; n < 2; ++n) *(f32x4*)(rowp + bj * HALF + n * 16) = acc[ai][bj][m][n]; }
    }
};
struct EpiScale {
    static constexpr bool PERM = true, AFTER_DRAIN = false;
    bf16_t* O; int ldc; const float* rowscale;
    __device__ __forceinline__ void operator()(const f32x4 (&acc)[2][2][4][2], const Unit& u, int wr, int wc, int fr, int fq) const {
        const int row0 = u.pm * BM + wr * 64 + fr, col0 = u.pn * BM + wc * 32 + 8 * fq;
        float sv[2][4];
#pragma unroll
        for (int ai = 0; ai < 2; ++ai)
#pragma unroll
            for (int m = 0; m < 4; ++m) sv[ai][m] = rowscale[row0 + ai * HALF + m * 16];
#pragma unroll
        for (int ai = 0; ai < 2; ++ai)
#pragma unroll
            for (int m = 0; m < 4; ++m) { const int row = row0 + ai * HALF + m * 16; const float s = sv[ai][m]; bf16_t* rowp = O + (size_t)row * ldc + col0;
#pragma unroll
                for (int bj = 0; bj < 2; ++bj) { const f32x4 v0 = acc[ai][bj][m][0] * s, v1 = acc[ai][bj][m][1] * s;
                    u32x4 w; w.x = cvt_pk_bf16(v0[0], v0[1]); w.y = cvt_pk_bf16(v0[2], v0[3]); w.z = cvt_pk_bf16(v1[0], v1[1]); w.w = cvt_pk_bf16(v1[2], v1[3]);
                    *(u32x4*)(rowp + bj * HALF) = w; } }
    }
};

template <class Epi, class Sched, bool ALIGN_EPI = false, bool SP2 = false>
__device__ __forceinline__ void gemm_phase(PG8_LAS unsigned char* lds, const Gemm g, const Sched& S, const Epi& E) {
    int tid_l = threadIdx.x; asm volatile("" : "+v"(tid_l));
    const int tid = tid_l, wid = __builtin_amdgcn_readfirstlane(tid >> 6), lane = tid & 63, wr = wid >> 2, wc = wid & 3, fr = lane & 15, fq = lane >> 4;
    const int K = g.K, nt = K / BK;
    unsigned voffA[2], voffB[2];
#pragma unroll
    for (int i = 0; i < 2; ++i) { int R, C; stage_rc(tid * 16 + i * 8192, R, C); const int Rb = Epi::PERM ? ((R & ~31) + perm32(R & 31)) : R;
        voffA[i] = (unsigned)(R * g.ld + C) * 2u; voffB[i] = (unsigned)(Rb * g.ld + C) * 2u; }
    const size_t kstep = (size_t)(BK * 2);
    const size_t hstep = (size_t)HALF * g.ld * 2;
    const size_t tstep = 2 * hstep;
    const unsigned ldsw = (unsigned)wid * 1024u;
    const int aoff = lds_byte(wr * 64 + fr, fq * 8), boff = lds_byte(wc * 32 + fr, fq * 8);
#define PG8_SA(b, h) (((b) * 2 + (h)) * HTB)
#define PG8_SB(b, h) ((4 + (b) * 2 + (h)) * HTB)
#define PG8_STAGE(bufoff, gbase, voff) do { _Pragma("unroll") for (int _i = 0; _i < 2; ++_i) \
        __builtin_amdgcn_global_load_lds((const unsigned*)((const char*)(gbase) + (voff)[_i]), (PG8_LAS unsigned*)(lds + (bufoff) + ldsw + _i * 8192), 16, 0, 0); } while (0)
#define PG8_LDA(dst, b, h) do { _Pragma("unroll") for (int m = 0; m < 4; ++m) _Pragma("unroll") for (int k = 0; k < 2; ++k) dst[m][k] = *(const PG8_LAS bf16x8*)(lds + PG8_SA(b, h) + aoff + m * 2048 + k * 1024); } while (0)
#define PG8_LDB(dst, b, h) do { _Pragma("unroll") for (int n = 0; n < 2; ++n) _Pragma("unroll") for (int k = 0; k < 2; ++k) dst[n][k] = *(const PG8_LAS bf16x8*)(lds + PG8_SB(b, h) + boff + n * 2048 + k * 1024); } while (0)
#define PG8_MMA(ai, bj, At, Bt) do { __builtin_amdgcn_s_setprio(1); _Pragma("unroll") for (int m = 0; m < 4; ++m) _Pragma("unroll") for (int n = 0; n < 2; ++n) _Pragma("unroll") for (int k = 0; k < 2; ++k) \
        acc[ai][bj][m][n] = __builtin_amdgcn_mfma_f32_16x16x32_bf16(Bt[n][k], At[m][k], acc[ai][bj][m][n], 0, 0, 0); __builtin_amdgcn_s_setprio(0); } while (0)
#define PG8_WAIT_V(n) asm volatile("s_waitcnt vmcnt(" #n ")" ::: "memory")
#define PG8_WAIT_L(n) asm volatile("s_waitcnt lgkmcnt(" #n ")" ::: "memory")
#define PG8_BAR __builtin_amdgcn_s_barrier()
#define PG8_SCHED __builtin_amdgcn_sched_barrier(0)
    Unit cur, nxt; int ui = 0;
    if (!S.next(0, cur)) return;
    f32x4 acc[2][2][4][2];
#pragma unroll
    for (int a = 0; a < 2; ++a)
#pragma unroll
        for (int b = 0; b < 2; ++b)
#pragma unroll
            for (int m = 0; m < 4; ++m)
#pragma unroll
                for (int n = 0; n < 2; ++n) acc[a][b][m][n] = (f32x4){0.f, 0.f, 0.f, 0.f};
    bf16x8 At[4][2], B0[2][2], B1[2][2];
    const char* cA = (const char*)g.A + (size_t)cur.pm * tstep + (size_t)cur.koff * 2; const char* cB = (const char*)g.Bt + (size_t)cur.pb * tstep + (size_t)cur.koff * 2;
    S.a_ready(cur);
    if constexpr (SP2) {
        PG8_STAGE(PG8_SB(0, 0), cB, voffB); PG8_STAGE(PG8_SB(0, 1), cB + hstep, voffB); PG8_STAGE(PG8_SA(0, 0), cA, voffA); PG8_STAGE(PG8_SA(0, 1), cA + hstep, voffA);
        if (wr == 1) PG8_BAR;
        PG8_WAIT_V(2); PG8_BAR;
        PG8_STAGE(PG8_SB(1, 0), cB + kstep, voffB); PG8_STAGE(PG8_SA(1, 0), cA + kstep, voffA); PG8_STAGE(PG8_SB(1, 1), cB + hstep + kstep, voffB);
        PG8_WAIT_V(6); PG8_BAR;
    } else {
        PG8_STAGE(PG8_SB(0, 0), cB, voffB); PG8_STAGE(PG8_SA(0, 0), cA, voffA); PG8_STAGE(PG8_SB(0, 1), cB + hstep, voffB); PG8_STAGE(PG8_SA(0, 1), cA + hstep, voffA);
        if (wr == 1) PG8_BAR;
        PG8_WAIT_V(4); PG8_BAR;
        PG8_STAGE(PG8_SB(1, 0), cB + kstep, voffB); PG8_STAGE(PG8_SA(1, 0), cA + kstep, voffA); PG8_STAGE(PG8_SB(1, 1), cB + hstep + kstep, voffB);
        PG8_WAIT_V(6); PG8_BAR;
    }
    for (;;) {
        const bool has_next = S.next(ui + 1, nxt);
        const char* nA = has_next ? (const char*)g.A + (size_t)nxt.pm * tstep + (size_t)nxt.koff * 2 : cA; const char* nB = has_next ? (const char*)g.Bt + (size_t)nxt.pb * tstep + (size_t)nxt.koff * 2 : cB;
        for (int t = 0; t < nt; t += 2) {
            const bool last = (t == nt - 2);
            const char* a1 = cA + (size_t)(t + 1) * kstep;
            const char* a2 = last ? nA : cA + (size_t)(t + 2) * kstep; const char* b2 = last ? nB : cB + (size_t)(t + 2) * kstep;
            const char* a3 = a2 + kstep; const char* b3 = b2 + kstep;
            if (last && has_next) S.a_ready(nxt);
            if constexpr (SP2) {
            PG8_LDB(B0, 0, 0); PG8_LDB(B1, 0, 1); PG8_SCHED; PG8_LDA(At, 0, 0); PG8_STAGE(PG8_SA(1, 1), a1 + hstep, voffA);
            PG8_WAIT_V(8); PG8_WAIT_L(0); PG8_BAR; PG8_MMA(0, 0, At, B0); PG8_MMA(0, 1, At, B1); PG8_BAR; PG8_SCHED;
            PG8_LDA(At, 0, 1); PG8_STAGE(PG8_SB(0, 0), b2, voffB); PG8_STAGE(PG8_SB(0, 1), b2 + hstep, voffB); PG8_STAGE(PG8_SA(0, 0), a2, voffA);
            PG8_WAIT_V(8); PG8_WAIT_L(0); PG8_BAR; PG8_MMA(1, 0, At, B0); PG8_MMA(1, 1, At, B1); PG8_BAR; PG8_SCHED;
            PG8_LDB(B0, 1, 0); PG8_LDB(B1, 1, 1); PG8_SCHED; PG8_LDA(At, 1, 0); PG8_STAGE(PG8_SA(0, 1), a2 + hstep, voffA);
            PG8_WAIT_V(8); PG8_WAIT_L(0); PG8_BAR; PG8_MMA(0, 0, At, B0); PG8_MMA(0, 1, At, B1); PG8_BAR; PG8_SCHED;
            PG8_LDA(At, 1, 1); PG8_STAGE(PG8_SB(1, 0), b3, voffB); PG8_STAGE(PG8_SB(1, 1), b3 + hstep, voffB); PG8_STAGE(PG8_SA(1, 0), a3, voffA);
            PG8_WAIT_V(8); PG8_WAIT_L(0); PG8_BAR; PG8_MMA(1, 0, At, B0); PG8_MMA(1, 1, At, B1); PG8_BAR; PG8_SCHED;
            } else {
            PG8_LDB(B0, 0, 0); PG8_SCHED; PG8_LDA(At, 0, 0); PG8_STAGE(PG8_SA(1, 1), a1 + hstep, voffA);
            PG8_WAIT_L(8); PG8_BAR; PG8_WAIT_L(0); PG8_MMA(0, 0, At, B0); PG8_BAR; PG8_SCHED;
            PG8_LDB(B1, 0, 1); PG8_STAGE(PG8_SB(0, 0), b2, voffB);
            PG8_BAR; PG8_WAIT_L(0); PG8_MMA(0, 1, At, B1); PG8_BAR;
            PG8_LDA(At, 0, 1); PG8_STAGE(PG8_SA(0, 0), a2, voffA);
            PG8_BAR; PG8_WAIT_L(0); PG8_MMA(1, 0, At, B0); PG8_BAR; PG8_SCHED;
            PG8_STAGE(PG8_SB(0, 1), b2 + hstep, voffB);
            PG8_WAIT_V(6); PG8_BAR; PG8_MMA(1, 1, At, B1); PG8_BAR;
            PG8_LDB(B0, 1, 0); PG8_SCHED; PG8_LDA(At, 1, 0); PG8_STAGE(PG8_SA(0, 1), a2 + hstep, voffA);
            PG8_WAIT_L(8); PG8_BAR; PG8_WAIT_L(0); PG8_MMA(0, 0, At, B0); PG8_BAR; PG8_SCHED;
            PG8_LDB(B1, 1, 1); PG8_STAGE(PG8_SB(1, 0), b3, voffB);
            PG8_BAR; PG8_WAIT_L(0); PG8_MMA(0, 1, At, B1); PG8_BAR;
            PG8_LDA(At, 1, 1); PG8_STAGE(PG8_SA(1, 0), a3, voffA);
            PG8_BAR; PG8_WAIT_L(0); PG8_MMA(1, 0, At, B0); PG8_BAR; PG8_SCHED;
            PG8_STAGE(PG8_SB(1, 1), b3 + hstep, voffB);
            PG8_WAIT_V(6); PG8_BAR; PG8_MMA(1, 1, At, B1); PG8_BAR;
            }
        }
        if constexpr (ALIGN_EPI) { if (wr == 0) PG8_BAR; }
        if constexpr (!Epi::AFTER_DRAIN) { E(acc, cur, wr, wc, fr, fq); S.done(cur); }
        if (!has_next) break;
#pragma unroll
        for (int a = 0; a < 2; ++a)
#pragma unroll
            for (int b = 0; b < 2; ++b)
#pragma unroll
                for (int m = 0; m < 4; ++m)
#pragma unroll
                    for (int n = 0; n < 2; ++n) acc[a][b][m][n] = (f32x4){0.f, 0.f, 0.f, 0.f};
        cur = nxt; cA = nA; cB = nB; ++ui;
        if constexpr (ALIGN_EPI) { if (wr == 1) PG8_BAR; }
    }
    PG8_WAIT_V(0);
    if constexpr (!ALIGN_EPI) { if (wr == 0) PG8_BAR; }
    PG8_BAR;
    if constexpr (Epi::AFTER_DRAIN) { E.fused(acc, cur, wr, wc, fr, fq, lds, wid, lane); S.done(cur); }
#undef PG8_SA
#undef PG8_SB
#undef PG8_STAGE
#undef PG8_LDA
#undef PG8_LDB
#undef PG8_MMA
#undef PG8_WAIT_V
#undef PG8_WAIT_L
#undef PG8_BAR
#undef PG8_SCHED
}
}

constexpr int NWAVES = 8;
#ifndef MK_PER_PHASE
#define MK_PER_PHASE 0
#endif

constexpr int BATCH = 4, SEQ = 4096, D = 1024, M = BATCH * SEQ;
constexpr int INE = 1536, AW = 512, NHEAD = 8, HD = 64, CHUNK = 128, BW = 512, NGRP = 4, GD = 128;
constexpr int FFD = 2816, NEXP = 8, FFX = 3584, CONVK = 31;
constexpr float EPS = 1e-6f;
constexpr int MSLOT = 2 * M + NEXP * 256;
constexpr int DNX_FULL = 128, DNX_NS = 7, DNX_KS = 512;
constexpr int NPH = 31;

constexpr size_t MiB = 1u << 20;
constexpr size_t WS_CTL = 0, CTL_ZERO_BYTES = 1 * MiB;
constexpr size_t WS_WE = 1 * MiB, WE_STRIDE = 23 * MiB;
constexpr size_t WE_IN = 0, WE_OUT = 3 * MiB, WE_GU = 5 * MiB, WE_DN = 16 * MiB, WE_SP = 21 * MiB + 512 * 1024, WE_PL = 21 * MiB + 768 * 1024;
constexpr size_t WS_WO = 47 * MiB, WO_STRIDE = 174 * MiB;
constexpr size_t WO_PW1 = 0, WO_PW2 = 4 * MiB, WO_GUX = 6 * MiB, WO_DNX = 118 * MiB;
constexpr size_t WS_H = 395 * MiB;
constexpr size_t WS_HN = 459 * MiB;
constexpr size_t WS_R = 491 * MiB;
constexpr size_t WS_PROJ = WS_R, WS_MIX = WS_R + 48 * MiB, WS_ACT = WS_R + 80 * MiB;
constexpr size_t WS_GLU = WS_R, WS_CV = WS_R + 32 * MiB;
constexpr size_t WS_HP = WS_R, WS_ACTX = WS_R + 68 * MiB, WS_Y = WS_R + 306 * MiB;
constexpr size_t WS_PART = WS_R;
constexpr size_t WS_TOKINFO = 865 * MiB, WS_TOKSLOT = WS_TOKINFO + 256 * 1024, WS_SLOTGATE = WS_TOKSLOT + 128 * 1024, WS_CNTTAB = WS_SLOTGATE + 136 * 1024, WS_END = 866 * MiB;
static_assert(WS_WE + 2 * WE_STRIDE <= WS_WO && WS_WO + 2 * WO_STRIDE <= WS_H && WS_H + (size_t)M * D * 4 <= WS_HN && WS_HN + (size_t)M * D * 2 <= WS_R, "ws map");
static_assert(WS_ACT + (size_t)M * FFD * 2 <= WS_TOKINFO && WS_ACTX + (size_t)MSLOT * FFX * 2 <= WS_Y && WS_Y + (size_t)MSLOT * D * 2 <= WS_TOKINFO && (size_t)MSLOT * D * 2 <= 68 * MiB, "ws map 2");
static_assert(WS_SLOTGATE + (size_t)MSLOT * 4 <= WS_CNTTAB && WS_CNTTAB + (size_t)(M / 64) * NEXP * 4 <= WS_END && WS_END <= 896 * MiB, "ws map 3");
constexpr int CW_TMO = 0, CW_CODE = 1;
constexpr int CW_BAR = 4096;
constexpr int CW_CONVQ = 7936;
constexpr int CW_CONVSNAP = 7680;
constexpr int CW_MOE = 8192;

constexpr int RING_OFF = 0, RING_BYTES = 141312;
constexpr int LDSCTL_OFF = RING_BYTES, MISC_OFF = LDSCTL_OFF + 320;
constexpr int LDS_BYTES = 147456;
static_assert(MISC_OFF + 128 <= LDS_BYTES, "LDS map");

#define GAS __attribute__((address_space(1)))
#define LAS __attribute__((address_space(3)))
typedef unsigned short bf16;
typedef unsigned v4u __attribute__((ext_vector_type(4)));
typedef float f32x4 __attribute__((ext_vector_type(4)));
typedef short bf16x8 __attribute__((ext_vector_type(8)));
typedef GAS unsigned gu32;
typedef GAS unsigned long long gu64;
#define RLX_AGENT __ATOMIC_RELAXED, __HIP_MEMORY_SCOPE_AGENT
#define LDS_WAIT() asm volatile("s_waitcnt lgkmcnt(0)" ::: "memory")
#define VM_WAIT() asm volatile("s_waitcnt vmcnt(0)" ::: "memory")
__device__ __forceinline__ unsigned long long rt() { return __builtin_amdgcn_s_memrealtime(); }
__device__ __forceinline__ unsigned f2bf(float f) { unsigned u = __builtin_bit_cast(unsigned, f); return (u + 0x7fffu + ((u >> 16) & 1u)) >> 16; }
__device__ __forceinline__ unsigned pk2(float lo, float hi) { return f2bf(lo) | (f2bf(hi) << 16); }

#define XB_TMO      128
#define XB_XCNT(j)  (256  + 64 * (j))
#define XB_XSUB(j)  (1280 + 64 * (j))
#define XB_XGEN(j)  (2304 + 64 * (j))
#define XB_TOP      3328
#define XB_TOPGEN   3392
#define XCD_BAR_WORDS 3456
#define XB_SPIN_CAP (1u << 18)

__device__ __forceinline__ unsigned xb_ld(unsigned* p)              { return __hip_atomic_load(p, __ATOMIC_RELAXED, __HIP_MEMORY_SCOPE_AGENT); }
__device__ __forceinline__ unsigned xb_add(unsigned* p, unsigned v) { return __hip_atomic_fetch_add(p, v, __ATOMIC_RELAXED, __HIP_MEMORY_SCOPE_AGENT); }
__device__ __forceinline__ unsigned xb_xcc_id() { return (unsigned)__builtin_amdgcn_s_getreg((3 << 11) | 20) & 0xFu; }
#define XB_SPIN(cond, bar) do { unsigned _sp = 0; while (cond) { __builtin_amdgcn_s_sleep(1); \
    if ((++_sp & 255u) == 0u) { if (xb_ld(&(bar)[XB_TMO])) break; if (_sp > XB_SPIN_CAP) { atomicAdd(&(bar)[XB_TMO], 1u); break; } } } } while (0)

struct XcdBarrier {
    unsigned* bar; unsigned x;
    volatile LAS unsigned* st;
};

__device__ __forceinline__ XcdBarrier xcd_barrier_post(unsigned* bar, volatile LAS unsigned* st) {
    XcdBarrier b; b.bar = bar; b.x = xb_xcc_id(); b.st = st;
    if (threadIdx.x == 0) (void)xb_add(&bar[XB_XCNT(b.x)], 1u);
    return b;
}
__device__ __forceinline__ void xcd_barrier_complete(unsigned* bar, unsigned x, unsigned& nloc, unsigned& nx) {
    const unsigned G = gridDim.x * gridDim.y * gridDim.z;
    unsigned sum, cnt, mine, sp = 0u;
    for (;;) {
        sum = 0u; cnt = 0u; mine = 0u;
#pragma unroll 1
        for (unsigned j = 0; j < 16; ++j) { const unsigned c = xb_ld(&bar[XB_XCNT(j)]); sum += c; cnt += (c > 0u) ? 1u : 0u; mine = (j == x) ? c : mine; }
        if (sum == G) break;
        __builtin_amdgcn_s_sleep(1);
        if ((++sp & 255u) == 0u) { if (xb_ld(&bar[XB_TMO])) break; if (sp > XB_SPIN_CAP) { atomicAdd(&bar[XB_TMO], 1u); break; } }
    }
    nloc = mine > 0u ? mine : 1u; nx = cnt > 0u ? cnt : 1u;
}

__device__ __forceinline__ void xcd_barrier(const XcdBarrier& b) {
    asm volatile("s_waitcnt vmcnt(0)" ::: "memory");
    __syncthreads();
    if (threadIdx.x == 0) {
        unsigned* bar = b.bar;
        __builtin_amdgcn_s_waitcnt(0);
        unsigned nloc = b.st[0], nx = b.st[1];
        if (nloc == 0u) { xcd_barrier_complete(bar, b.x, nloc, nx); b.st[0] = nloc; b.st[1] = nx; }
        const unsigned old = xb_add(&bar[XB_XSUB(b.x)], 1u);
        const unsigned gen = old / nloc;
        if (old + 1u == (gen + 1u) * nloc) {
            __builtin_amdgcn_fence(__ATOMIC_RELEASE, "agent");
            asm volatile("s_waitcnt vmcnt(0)" ::: "memory");
            const unsigned og = xb_add(&bar[XB_TOP], 1u);
            const unsigned tg = og / nx;
            if (og + 1u == (tg + 1u) * nx) xb_add(&bar[XB_TOPGEN], 1u);
            else XB_SPIN(xb_ld(&bar[XB_TOPGEN]) == tg, bar);
            __builtin_amdgcn_fence(__ATOMIC_ACQUIRE, "agent");
            xb_add(&bar[XB_XGEN(b.x)], 1u);
            asm volatile("s_waitcnt vmcnt(0)" ::: "memory");
        } else {
            XB_SPIN(xb_ld(&bar[XB_XGEN(b.x)]) == gen, bar);
            __builtin_amdgcn_fence(__ATOMIC_ACQUIRE, "agent");
            asm volatile("s_waitcnt vmcnt(0)" ::: "memory");
        }
    }
    __syncthreads();
}

typedef float f32x2 __attribute__((ext_vector_type(2)));
typedef unsigned u32x2 __attribute__((ext_vector_type(2)));
typedef int i32x4 __attribute__((ext_vector_type(4)));
typedef int i32x2 __attribute__((ext_vector_type(2)));
struct Frame {
    LAS unsigned char* lds;
    volatile LAS unsigned* MISC;
    gu32* ctl;
    int tid, lane, wave;
    int vcu, G;
    const float* const* in;
    unsigned char* ws; float* out;
};
__device__ __forceinline__ float bf_lo(unsigned u) { return __uint_as_float(u << 16); }
__device__ __forceinline__ float bf_hi(unsigned u) { return __uint_as_float(u & 0xffff0000u); }
__device__ __forceinline__ unsigned pkbf(float lo, float hi) { return pg8::cvt_pk_bf16(lo, hi); }
__device__ __forceinline__ float wave_sum(float v) {
#pragma unroll
    for (int o = 1; o < 64; o <<= 1) v += __shfl_xor(v, o);
    return v;
}
__device__ __forceinline__ float dot4(f32x4 a, f32x4 b) { return (a.x * b.x + a.y * b.y) + (a.z * b.z + a.w * b.w); }
__device__ __forceinline__ float silu_f(float x) { return x * pg8::fast_sigmoid(x); }

#define P0_LOAD(R, src, ldn) do { _Pragma("unroll") for (int j_ = 0; j_ < 16; ++j_) R[j_] = __builtin_nontemporal_load((const f32x4*)((src) + (size_t)(4 * j_ + (lane >> 4)) * (ldn) + 4 * (lane & 15))); } while (0)
constexpr int I_IN = 16 * 24, I_OUT = 16 * 16, I_GD = 16 * 44, I_DN = 44 * 16, I_PW1 = 16 * 16  , I_PW2 = 16 * 16, I_GX = 16 * 56  , I_DX = 56 * 16  , I_PL = 4  ;
constexpr int NIT_ST = I_IN + I_OUT + 2 * I_GD + I_DN + 2 * I_PW1 + I_PW2 + NGRP * I_PL, NIT_MOE = NEXP * (2 * I_GX + I_DX), CONV_CHUNK = 4;
static_assert(NIT_MOE % CONV_CHUNK == 0, "queue chunks never straddle a layer pair");
#define KIN(k) ({ const float* const* p_ = kargs; asm volatile("" : "+s"(p_)); p_[k]; })
#define P0_PAIR(Wp, K_, N_, dstp, half, q) do { const int nb_ = (N_) / 64, kb_ = (q) / nb_, n0_ = ((q) % nb_) * 64; src = (Wp) + (size_t)(kb_ * 64) * (N_) + n0_; ldn = (N_); \
        dst = (dstp) + (size_t)((n0_ >> 7) * 256 + (half) * 128 + (n0_ & 127)) * (K_) + kb_ * 64; ldk = (K_); } while (0)
#define P0_PLAIN(Wp, K_, N_, dstp, q) do { const int nb_ = (N_) / 64, kb_ = (q) / nb_, n0_ = ((q) % nb_) * 64; src = (Wp) + (size_t)(kb_ * 64) * (N_) + n0_; ldn = (N_); dst = (dstp) + (size_t)n0_ * (K_) + kb_ * 64; ldk = (K_); } while (0)
template <bool MOE> __device__ __forceinline__ void p0_item_addr(int gidx, const float* const* kargs, unsigned char* ws, const float*& src, int& ldn, bf16*& dst, int& ldk) {
    if constexpr (MOE) {
        const int li = gidx / NIT_MOE; int r = gidx % NIT_MOE; unsigned char* wo = ws + WS_WO + (size_t)li * WO_STRIDE;
        if (r < NEXP * I_GX) { const int e = r / I_GX; P0_PAIR(KIN(24) + ((size_t)li * NEXP + e) * D * FFX, D, FFX, (bf16*)(wo + WO_GUX) + (size_t)e * 2 * FFX * D, 0, r % I_GX); return; } r -= NEXP * I_GX;
        if (r < NEXP * I_GX) { const int e = r / I_GX; P0_PAIR(KIN(25) + ((size_t)li * NEXP + e) * D * FFX, D, FFX, (bf16*)(wo + WO_GUX) + (size_t)e * 2 * FFX * D, 1, r % I_GX); return; } r -= NEXP * I_GX;
        { const int e = r / I_DX; P0_PLAIN(KIN(26) + ((size_t)li * NEXP + e) * FFX * D, FFX, D, (bf16*)(wo + WO_DNX) + (size_t)e * D * FFX, r % I_DX); }
    } else {
        const int li = gidx / NIT_ST; int r = gidx % NIT_ST; unsigned char* we = ws + WS_WE + (size_t)li * WE_STRIDE; unsigned char* wo = ws + WS_WO + (size_t)li * WO_STRIDE;
        if (r < I_IN) { P0_PLAIN(KIN(2) + (size_t)li * D * INE, D, INE, (bf16*)(we + WE_IN), r); return; } r -= I_IN;
        if (r < I_OUT) { P0_PLAIN(KIN(8) + (size_t)li * D * D, D, D, (bf16*)(we + WE_OUT), r); return; } r -= I_OUT;
        if (r < I_GD) { P0_PAIR(KIN(10) + (size_t)li * D * FFD, D, FFD, (bf16*)(we + WE_GU), 0, r); return; } r -= I_GD;
        if (r < I_GD) { P0_PAIR(KIN(11) + (size_t)li * D * FFD, D, FFD, (bf16*)(we + WE_GU), 1, r); return; } r -= I_GD;
        if (r < I_DN) { P0_PLAIN(KIN(12) + (size_t)li * FFD * D, FFD, D, (bf16*)(we + WE_DN), r); return; } r -= I_DN;
        if (r < 2 * I_PW1) { const int half = r / I_PW1, q = r % I_PW1, kb = q / 16, n0 = (q % 16) * 64;
            src = KIN(14) + (size_t)li * D * 2 * D + (size_t)(kb * 64) * (2 * D) + half * D + n0; ldn = 2 * D; dst = (bf16*)(wo + WO_PW1) + (size_t)((n0 >> 7) * 256 + half * 128 + (n0 & 127)) * D + kb * 64; ldk = D; return; } r -= 2 * I_PW1;
        if (r < I_PW2) { P0_PLAIN(KIN(20) + (size_t)li * D * D, D, D, (bf16*)(wo + WO_PW2), r); return; } r -= I_PW2;
        { const int g = r / I_PL; P0_PLAIN(KIN(6) + ((size_t)li * NGRP + g) * GD * GD, GD, GD, (bf16*)(we + WE_PL) + (size_t)g * GD * GD, r % I_PL); }
    }
}
#undef P0_PAIR
#undef P0_PLAIN
template <bool MOE> __device__ __forceinline__ void conv_items(const float* const* kargs, unsigned char* ws, LAS float* scr, int lane, int first, int step, int count) {
    if (count <= 0) return;
    const float* src = nullptr; int ldn = 0; bf16* dst = nullptr; int ldk = 0;
    f32x4 A[16], B[16];
    p0_item_addr<MOE>(first, kargs, ws, src, ldn, dst, ldk); P0_LOAD(A, src, ldn);
    for (int k = 0; k < count; ++k) {
        const bool hn = (k + 1 < count);
        const float* src1 = nullptr; int ldn1 = 0; bf16* dst1 = nullptr; int ldk1 = 0;
        if (hn) { p0_item_addr<MOE>(first + (k + 1) * step, kargs, ws, src1, ldn1, dst1, ldk1); P0_LOAD(B, src1, ldn1); }
#pragma unroll
        for (int j = 0; j < 16; ++j) { LAS float* p = scr + (4 * j + (lane >> 4)) * 65 + 4 * (lane & 15); p[0] = A[j].x; p[1] = A[j].y; p[2] = A[j].z; p[3] = A[j].w; }
        LDS_WAIT(); asm volatile("" ::: "memory");
        { const int c = lane & 7;
#pragma unroll
          for (int j = 0; j < 8; ++j) { const int n = (lane >> 3) + 8 * j; const LAS float* s = scr + (8 * c) * 65 + n;
              v4u o; o.x = pkbf(s[0 * 65], s[1 * 65]); o.y = pkbf(s[2 * 65], s[3 * 65]); o.z = pkbf(s[4 * 65], s[5 * 65]); o.w = pkbf(s[6 * 65], s[7 * 65]);
              *(GAS v4u*)(dst + (size_t)n * ldk + 8 * c) = o; } }
        LDS_WAIT(); asm volatile("" ::: "memory");
        if (hn) {
#pragma unroll
            for (int j = 0; j < 16; ++j) A[j] = B[j];
            dst = dst1; ldk = ldk1; }
    }
}
__device__ __forceinline__ void conv_pull_block(Frame& F, const float* const* kargs) {
    int tid_l = F.tid; asm volatile("" : "+v"(tid_l)); const int tid = tid_l, lane = tid & 63, wave = __builtin_amdgcn_readfirstlane(tid >> 6);
    LAS float* scr = (LAS float*)(F.lds + RING_OFF + wave * 16640);
    gu32* q = F.ctl + CW_CONVQ;
    if (tid == 0) F.MISC[12] = __hip_atomic_fetch_add(q, (unsigned)(CONV_CHUNK * NWAVES), RLX_AGENT);
    __syncthreads();
    const unsigned base = (unsigned)__builtin_amdgcn_readfirstlane((int)F.MISC[12]) + (unsigned)(CONV_CHUNK * wave);
    if (base < 2u * NIT_MOE) conv_items<true>(kargs, F.ws, scr, lane, (int)base, 1, CONV_CHUNK);
    __syncthreads();
}
__device__ __forceinline__ void conv_drain(Frame& F, const float* const* kargs, int li) {
    int tid_l = F.tid; asm volatile("" : "+v"(tid_l)); const int tid = tid_l, lane = tid & 63, wave = __builtin_amdgcn_readfirstlane(tid >> 6);
    LAS float* scr = (LAS float*)(F.lds + RING_OFF + wave * 16640);
    const int end = (li + 1) * NIT_MOE;
    const int snap = __builtin_amdgcn_readfirstlane((int)__hip_atomic_load(F.ctl + CW_CONVSNAP + 64 * li, RLX_AGENT));
    if (blockIdx.x == 0 && tid == 0) __hip_atomic_fetch_max(F.ctl + CW_CONVQ, (unsigned)end, RLX_AGENT);
    const int gw = F.vcu * NWAVES + wave, NGW = F.G * NWAVES, first = snap + gw;
    conv_items<true>(kargs, F.ws, scr, lane, first, NGW, first < end ? (end - 1 - first) / NGW + 1 : 0);
}
__device__ __forceinline__ void p0_prologue(Frame& F, const float* const* kargs) {
    int tid_l = F.tid; asm volatile("" : "+v"(tid_l)); const int tid = tid_l, lane = tid & 63, wave = __builtin_amdgcn_readfirstlane(tid >> 6); (void)tid; (void)lane; (void)wave;
    LAS float* scr = (LAS float*)(F.lds + RING_OFF + wave * 16640);
    const int gw = F.vcu * NWAVES + wave, NGW = F.G * NWAVES;
    conv_items<false>(kargs, F.ws, scr, lane, gw, NGW, gw < 2 * NIT_ST ? (2 * NIT_ST - 1 - gw) / NGW + 1 : 0);
    for (int li = 0; li < 2; ++li) { const float* wsp = KIN(4) + (size_t)li * NHEAD * CHUNK * CHUNK; bf16* dsp = (bf16*)(F.ws + WS_WE + (size_t)li * WE_STRIDE + WE_SP);
        for (int q = (F.vcu * NWAVES * 64 + tid); q < NHEAD * CHUNK * CHUNK / 4; q += F.G * NWAVES * 64) {
            const int e0 = q * 4, t = (e0 >> 7) & 127, s = e0 & 127; const f32x4 v = *(const f32x4*)(wsp + e0);
            u32x2 o; o.x = pkbf(s + 0 <= t ? v.x : 0.f, s + 1 <= t ? v.y : 0.f); o.y = pkbf(s + 2 <= t ? v.z : 0.f, s + 3 <= t ? v.w : 0.f);
            *(GAS u32x2*)(dsp + e0) = o; } }
}
__device__ __forceinline__ void rms_phase(Frame& F, const float* src, const float* gain, bf16* dst) {
    int tid_l = F.tid; asm volatile("" : "+v"(tid_l)); const int tid = tid_l, lane = tid & 63, wave = __builtin_amdgcn_readfirstlane(tid >> 6); (void)tid; (void)lane; (void)wave;
    const int gw = F.vcu * NWAVES + wave, NGW = F.G * NWAVES;
    f32x4 g[4];
#pragma unroll
    for (int j = 0; j < 4; ++j) g[j] = *(const f32x4*)(gain + 4 * lane + 256 * j);
    for (int m = gw; m < M; m += NGW) {
        const GAS f32x4* xr = (const GAS f32x4*)(src + (size_t)m * D) + lane;
        f32x4 v[4]; float s = 0.f;
#pragma unroll
        for (int j = 0; j < 4; ++j) { v[j] = xr[64 * j]; s += dot4(v[j], v[j]); }
        const float rstd = 1.0f / sqrtf(wave_sum(s) * (1.f / D) + EPS);
        GAS u32x2* o8 = (GAS u32x2*)(dst + (size_t)m * D) + lane;
#pragma unroll
        for (int j = 0; j < 4; ++j) { const f32x4 y = v[j] * rstd * g[j]; u32x2 w; w.x = pkbf(y.x, y.y); w.y = pkbf(y.z, y.w); o8[64 * j] = w; }
    }
}
constexpr int TSTR = 272;
template <int WIN> __device__ __forceinline__ void pool_rows(const bf16* zb, size_t tokr, int p0, LAS unsigned char* T, int lane) {
    unsigned zr[64 + WIN];
#pragma unroll
    for (int j = 0; j < 64 + WIN; ++j) { const bool valid = (p0 - WIN + j >= 0); const size_t row = valid ? tokr + j - WIN : tokr;
        const unsigned q = *(const GAS unsigned*)(zb + row * INE); zr[j] = valid ? q : 0u; }
    float sx = 0.f, sy = 0.f;
#pragma unroll
    for (int j = 0; j < WIN; ++j) { sx += bf_lo(zr[j]); sy += bf_hi(zr[j]); }
#pragma unroll
    for (int i = 0; i < 64; ++i) { const float zx = bf_lo(zr[WIN + i]), zy = bf_hi(zr[WIN + i]);
        sx += zx - bf_lo(zr[i]); sy += zy - bf_hi(zr[i]);
        const int cnt = (p0 + i + 1 < WIN) ? (p0 + i + 1) : WIN; const float inv = 1.0f / (float)cnt;
        *(LAS unsigned*)(T + i * TSTR + lane * 4) = pkbf(sx * inv - zx, sy * inv - zy); }
}
__device__ __forceinline__ void mixer_phase(Frame& F, int li, const float* sgu_norm, const float* b_spatial, const float* pool_scale, int only_part = -1) {
    int tid_l = F.tid; asm volatile("" : "+v"(tid_l)); const int tid = tid_l, lane = tid & 63, wave = __builtin_amdgcn_readfirstlane(tid >> 6); (void)tid; (void)lane; (void)wave;
    const bf16* proj = (const bf16*)(F.ws + WS_PROJ); bf16* mix = (bf16*)(F.ws + WS_MIX);
    const bf16* wsp = (const bf16*)(F.ws + WS_WE + (size_t)li * WE_STRIDE + WE_SP); const bf16* wpl = (const bf16*)(F.ws + WS_WE + (size_t)li * WE_STRIDE + WE_PL);
    LAS float* rs = (LAS float*)(F.lds + RING_OFF);
    LAS unsigned char* T = F.lds + RING_OFF + 512 + wave * (64 * TSTR);
    for (int u = F.vcu; u < 2 * (M / CHUNK); u += F.G) {
        const int chunk = u >> 1, part = u & 1, tok0 = chunk * CHUNK;
        if (only_part >= 0 && part != only_part) continue;
        int lane_u = lane; asm volatile("" : "+v"(lane_u));
        if (part == 0) {
            const int h = wave, rp = lane_u >> 3, cg = lane_u & 7;
            const bf16* Wh = wsp + (size_t)h * CHUNK * CHUNK; const float* bs = b_spatial + (li * NHEAD + h) * CHUNK;
            const bf16* vbase = proj + (size_t)tok0 * INE + AW;
            { v4u q[16];
#pragma unroll
              for (int r = 0; r < 16; ++r) q[r] = *(const GAS v4u*)(vbase + (size_t)(wave * 16 + r) * INE + lane_u * 8);
#pragma unroll
              for (int r = 0; r < 16; ++r) { float s = 0.f;
#pragma unroll
                  for (int k = 0; k < 4; ++k) { const float a = bf_lo(q[r][k]), b = bf_hi(q[r][k]); s += a * a + b * b; }
                  s = wave_sum(s); if (lane_u == 0) rs[wave * 16 + r] = 1.0f / sqrtf(s * (1.f / AW) + EPS); } }
            __syncthreads();
            { const f32x4 ga = *(const f32x4*)(sgu_norm + li * AW + h * HD + cg * 8), gb = *(const f32x4*)(sgu_norm + li * AW + h * HD + cg * 8 + 4);
              const float gv[8] = {ga.x, ga.y, ga.z, ga.w, gb.x, gb.y, gb.z, gb.w};
              v4u q0[8], q1[8];
#pragma unroll
              for (int st = 0; st < 8; ++st) { const int s = st * 16 + 2 * rp;
                  q0[st] = *(const GAS v4u*)(vbase + (size_t)s * INE + h * HD + cg * 8); q1[st] = *(const GAS v4u*)(vbase + (size_t)(s + 1) * INE + h * HD + cg * 8); }
#pragma unroll
              for (int st = 0; st < 8; ++st) { const int s = st * 16 + 2 * rp; const float r0 = rs[s], r1 = rs[s + 1];
#pragma unroll
                  for (int k = 0; k < 4; ++k) {
                      *(LAS unsigned*)(T + (cg * 8 + 2 * k) * TSTR + s * 2) = pkbf(bf_lo(q0[st][k]) * r0 * gv[2 * k], bf_lo(q1[st][k]) * r1 * gv[2 * k]);
                      *(LAS unsigned*)(T + (cg * 8 + 2 * k + 1) * TSTR + s * 2) = pkbf(bf_hi(q0[st][k]) * r0 * gv[2 * k + 1], bf_hi(q1[st][k]) * r1 * gv[2 * k + 1]); } } }
            LDS_WAIT(); asm volatile("" ::: "memory");
#pragma unroll
            for (int hf = 0; hf < 2; ++hf) {
                int lane_c = lane_u; asm volatile("" : "+v"(lane_c)); const int fr = lane_c & 15, fq = lane_c >> 4;
                bf16x8 bw[4][4]; u32x2 uu[4][4]; float bt[4];
#pragma unroll
                for (int t4 = 0; t4 < 4; ++t4) { const int ti = 4 * hf + t4; bt[t4] = bs[16 * ti + fr];
#pragma unroll
                    for (int ks = 0; ks < 4; ++ks) if (ks <= ti / 2) bw[t4][ks] = *(const GAS bf16x8*)(Wh + (size_t)(16 * ti + fr) * CHUNK + 32 * ks + 8 * fq);
#pragma unroll
                    for (int dj = 0; dj < 4; ++dj) uu[t4][dj] = *(const GAS u32x2*)(proj + ((size_t)tok0 + 16 * ti + fr) * INE + h * HD + 16 * dj + 4 * fq); }
#pragma unroll
                for (int t4 = 0; t4 < 4; ++t4) { const int ti = 4 * hf + t4;
                    const size_t tok = (size_t)tok0 + 16 * ti + fr;
#pragma unroll
                    for (int dj = 0; dj < 4; ++dj) {
                        f32x4 acc = (f32x4){0.f, 0.f, 0.f, 0.f};
#pragma unroll
                        for (int ks = 0; ks < 4; ++ks) if (ks <= ti / 2) { const bf16x8 a = *(const LAS bf16x8*)(T + (16 * dj + fr) * TSTR + (32 * ks + 8 * fq) * 2); acc = __builtin_amdgcn_mfma_f32_16x16x32_bf16(a, bw[t4][ks], acc, 0, 0, 0); }
                        const u32x2 uv = uu[t4][dj]; const float b = bt[t4];
                        u32x2 o; o.x = pkbf(bf_lo(uv.x) * (acc[0] + b), bf_hi(uv.x) * (acc[1] + b)); o.y = pkbf(bf_lo(uv.y) * (acc[2] + b), bf_hi(uv.y) * (acc[3] + b));
                        *(GAS u32x2*)(mix + tok * D + h * HD + 16 * dj + 4 * fq) = o;
                    }
                }
                asm volatile("" ::: "memory");
            }
        } else {
            const int g = wave >> 1, rh = wave & 1;
            const int p0 = (tok0 & (SEQ - 1)) + 64 * rh;
            const size_t tokr = (size_t)tok0 + 64 * rh;
            const bf16* Wp = wpl + (size_t)g * GD * GD;
            const bf16* zb = proj + 2 * AW + g * GD + 2 * lane_u;
            if (g == 0) pool_rows<2>(zb, tokr, p0, T, lane_u); else if (g == 1) pool_rows<4>(zb, tokr, p0, T, lane_u); else if (g == 2) pool_rows<8>(zb, tokr, p0, T, lane_u); else pool_rows<16>(zb, tokr, p0, T, lane_u);
            LDS_WAIT(); asm volatile("" ::: "memory");
            int lane_b = lane_u; asm volatile("" : "+v"(lane_b)); const int frb = lane_b & 15, fqb = lane_b >> 4;
            bf16x8 bm[4][4];
#pragma unroll
            for (int ti = 0; ti < 4; ++ti)
#pragma unroll
                for (int ks = 0; ks < 4; ++ks) bm[ti][ks] = *(const LAS bf16x8*)(T + (16 * ti + frb) * TSTR + (32 * ks + 8 * fqb) * 2);
#pragma unroll
            for (int half = 0; half < 2; ++half) {
                int lane_c = lane_u; asm volatile("" : "+v"(lane_c)); const int fr = lane_c & 15, fq = lane_c >> 4;
                bf16x8 aw[4][4]; f32x4 sc[4];
#pragma unroll
                for (int d4 = 0; d4 < 4; ++d4) { sc[d4] = *(const f32x4*)(pool_scale + li * BW + g * GD + 16 * (4 * half + d4) + 4 * fq);
#pragma unroll
                    for (int ks = 0; ks < 4; ++ks) aw[d4][ks] = *(const GAS bf16x8*)(Wp + (size_t)(16 * (4 * half + d4) + fr) * GD + 32 * ks + 8 * fq); }
#pragma unroll
                for (int d4 = 0; d4 < 4; ++d4) { const int dj = 4 * half + d4;
#pragma unroll
                    for (int ti = 0; ti < 4; ++ti) {
                        f32x4 acc = (f32x4){0.f, 0.f, 0.f, 0.f};
#pragma unroll
                        for (int ks = 0; ks < 4; ++ks) acc = __builtin_amdgcn_mfma_f32_16x16x32_bf16(aw[d4][ks], bm[ti][ks], acc, 0, 0, 0);
                        u32x2 o; o.x = pkbf(acc[0] * sc[d4].x, acc[1] * sc[d4].y); o.y = pkbf(acc[2] * sc[d4].z, acc[3] * sc[d4].w);
                        *(GAS u32x2*)(mix + (tokr + 16 * ti + fr) * D + AW + g * GD + 16 * dj + 4 * fq) = o;
                    } }
            }
        }
        __syncthreads();
    }
}
__device__ __forceinline__ void conv_phase(Frame& F, const float* w_dw, const float* b_dw, const float* ln_g, const float* ln_b) {
    int tid_l = F.tid; asm volatile("" : "+v"(tid_l)); const int tid = tid_l, lane = tid & 63, wave = __builtin_amdgcn_readfirstlane(tid >> 6); (void)tid; (void)lane; (void)wave;
    const bf16* glu = (const bf16*)(F.ws + WS_GLU); bf16* cvo = (bf16*)(F.ws + WS_CV);
    const int c0 = 2 * tid;
    f32x2 w[CONVK];
#pragma unroll
    for (int k = 0; k < CONVK; ++k) w[k] = *(const f32x2*)(w_dw + (size_t)k * D + c0);
    const f32x2 bd = *(const f32x2*)(b_dw + c0);
    for (int u = F.vcu; u < M / 64; u += F.G) {
        const int tok0 = u * 64; const bool hist = (tok0 & (SEQ - 1)) != 0;
        unsigned xin[94];
#pragma unroll
        for (int j = 0; j < 94; ++j) { const bool valid = (j >= 30) || hist; const size_t row = valid ? (size_t)(tok0 - 30 + j) : (size_t)tok0;
            const unsigned q = *(const GAS unsigned*)(glu + row * D + c0); xin[j] = valid ? q : 0u; }
#pragma unroll
        for (int s = 0; s < 4; ++s) {
            LAS float* cv = (LAS float*)(F.lds + RING_OFF + (s & 1) * 65536);
            f32x2 acc[16];
#pragma unroll
            for (int i = 0; i < 16; ++i) acc[i] = bd;
#pragma unroll
            for (int j = 0; j < 46; ++j) { const f32x2 x = (f32x2){bf_lo(xin[16 * s + j]), bf_hi(xin[16 * s + j])};
#pragma unroll
                for (int i = 0; i < 16; ++i) if (j - i >= 0 && j - i <= 30) acc[i] += w[j - i] * x; }
#pragma unroll
            for (int i = 0; i < 16; ++i) *(LAS f32x2*)(cv + i * D + c0) = acc[i];
            __syncthreads();
#pragma unroll
            for (int rr = 0; rr < 2; ++rr) { const int row = 2 * wave + rr;
                f32x4 v[4]; float sm = 0.f;
#pragma unroll
                for (int j = 0; j < 4; ++j) { v[j] = *(const LAS f32x4*)(cv + row * D + 4 * lane + 256 * j); sm += (v[j].x + v[j].y) + (v[j].z + v[j].w); }
                const float mean = wave_sum(sm) * (1.f / D); float s2 = 0.f;
#pragma unroll
                for (int j = 0; j < 4; ++j) { v[j] = v[j] - mean; s2 += dot4(v[j], v[j]); }
                const float rstd = 1.0f / sqrtf(wave_sum(s2) * (1.f / D) + EPS);
                GAS u32x2* o8 = (GAS u32x2*)(cvo + (size_t)(tok0 + 16 * s + row) * D) + lane;
#pragma unroll
                for (int j = 0; j < 4; ++j) { const f32x4 gg = *(const f32x4*)(ln_g + 4 * lane + 256 * j), bb = *(const f32x4*)(ln_b + 4 * lane + 256 * j);
                    const f32x4 y = v[j] * rstd * gg + bb; u32x2 o; o.x = pkbf(silu_f(y.x), silu_f(y.y)); o.y = pkbf(silu_f(y.z), silu_f(y.w)); o8[64 * j] = o; } }
        }
        __syncthreads();
    }
}
__device__ __forceinline__ void router_phase(Frame& F, const float* src, const float* gain, const float* w_router, bf16* dst) {
    int tid_l = F.tid; asm volatile("" : "+v"(tid_l)); const int tid = tid_l, lane = tid & 63, wave = __builtin_amdgcn_readfirstlane(tid >> 6); (void)tid; (void)lane; (void)wave;
    LAS float* wrT = (LAS float*)(F.lds + RING_OFF);
    LAS unsigned* lc = (LAS unsigned*)(F.lds + RING_OFF + 32768);
    for (int c = tid; c < D; c += NWAVES * 64) { const f32x4 a = *(const f32x4*)(w_router + (size_t)c * NEXP), b = *(const f32x4*)(w_router + (size_t)c * NEXP + 4);
        wrT[0 * D + c] = a.x; wrT[1 * D + c] = a.y; wrT[2 * D + c] = a.z; wrT[3 * D + c] = a.w; wrT[4 * D + c] = b.x; wrT[5 * D + c] = b.y; wrT[6 * D + c] = b.z; wrT[7 * D + c] = b.w; }
    f32x4 g[4];
#pragma unroll
    for (int j = 0; j < 4; ++j) g[j] = *(const f32x4*)(gain + 4 * lane + 256 * j);
    i32x4* tokinfo = (i32x4*)(F.ws + WS_TOKINFO); int* cnttab = (int*)(F.ws + WS_CNTTAB);
    for (int u = F.vcu; u < M / 64; u += F.G) {
        if (tid < NEXP) lc[tid] = 0u;
        __syncthreads();
        for (int q = 0; q < 8; ++q) { const int m = u * 64 + wave * 8 + q;
            const GAS f32x4* xr = (const GAS f32x4*)(src + (size_t)m * D) + lane;
            f32x4 v[4]; float s = 0.f;
#pragma unroll
            for (int j = 0; j < 4; ++j) { v[j] = xr[64 * j]; s += dot4(v[j], v[j]); }
            const float rstd = 1.0f / sqrtf(wave_sum(s) * (1.f / D) + EPS);
            GAS u32x2* o8 = (GAS u32x2*)(dst + (size_t)m * D) + lane;
#pragma unroll
            for (int j = 0; j < 4; ++j) { v[j] = v[j] * rstd * g[j]; u32x2 w; w.x = pkbf(v[j].x, v[j].y); w.y = pkbf(v[j].z, v[j].w); o8[64 * j] = w; }
            float lg[NEXP];
#pragma unroll
            for (int e = 0; e < NEXP; ++e) { float p = 0.f;
#pragma unroll
                for (int j = 0; j < 4; ++j) p += dot4(v[j], *(const LAS f32x4*)(wrT + e * D + 4 * lane + 256 * j));
                lg[e] = wave_sum(p); }
            int i1 = 0; float l1 = lg[0];
#pragma unroll
            for (int e = 1; e < NEXP; ++e) if (lg[e] > l1) { l1 = lg[e]; i1 = e; }
            int i2 = -1; float l2 = -INFINITY;
#pragma unroll
            for (int e = 0; e < NEXP; ++e) if (e != i1 && lg[e] > l2) { l2 = lg[e]; i2 = e; }
            const float g1 = 1.0f / (1.0f + __expf(l2 - l1)), g2 = 1.0f - g1;
            if (lane == 0) { tokinfo[m] = (i32x4){i1, i2, (int)__float_as_uint(g1), (int)__float_as_uint(g2)};
                __hip_atomic_fetch_add(&lc[i1], 1u, __ATOMIC_RELAXED, __HIP_MEMORY_SCOPE_WORKGROUP); __hip_atomic_fetch_add(&lc[i2], 1u, __ATOMIC_RELAXED, __HIP_MEMORY_SCOPE_WORKGROUP); }
        }
        __syncthreads();
        if (tid < NEXP) cnttab[u * NEXP + tid] = (int)lc[tid];
    }
}
__device__ __forceinline__ void scatter_phase(Frame& F, gu32* cnt) {
    int tid_l = F.tid; asm volatile("" : "+v"(tid_l)); const int tid = tid_l, lane = tid & 63, wave = __builtin_amdgcn_readfirstlane(tid >> 6); (void)tid; (void)lane; (void)wave;
    const bf16* hn = (const bf16*)(F.ws + WS_HN); bf16* hp = (bf16*)(F.ws + WS_HP);
    const i32x4* tokinfo = (const i32x4*)(F.ws + WS_TOKINFO); i32x2* tokslot = (i32x2*)(F.ws + WS_TOKSLOT); float* slotgate = (float*)(F.ws + WS_SLOTGATE);
    const int* cnttab = (const int*)(F.ws + WS_CNTTAB);
    LAS int* tot = (LAS int*)(F.lds + RING_OFF);
    LAS int* pre = tot + 8;
    LAS int* pbase = tot + 16;
    LAS int* le = tot + 32;
    LAS int* sl = tot + 160;
    for (int u = F.vcu; u < M / 64; u += F.G) {
        const int tok0 = u * 64;
        if (tid < 16) tot[tid] = 0;
        __syncthreads();
        { const int e = tid & 7, part = tid >> 3; int s_all = 0, s_pre = 0;
#pragma unroll
          for (int k = 0; k < (M / 64) / 64; ++k) { const int uu = part * ((M / 64) / 64) + k; const int c = cnttab[uu * NEXP + e]; s_all += c; s_pre += (uu < u) ? c : 0; }
          __hip_atomic_fetch_add(&tot[e], s_all, __ATOMIC_RELAXED, __HIP_MEMORY_SCOPE_WORKGROUP); __hip_atomic_fetch_add(&pre[e], s_pre, __ATOMIC_RELAXED, __HIP_MEMORY_SCOPE_WORKGROUP); }
        i32x4 info = (i32x4){0, 0, 0, 0};
        if (tid < 64) { info = tokinfo[tok0 + tid]; le[2 * tid] = info.x; le[2 * tid + 1] = info.y; }
        __syncthreads();
        if (tid == 0) { int acc = 0;
#pragma unroll
            for (int e = 0; e < NEXP; ++e) { const int t = tot[e]; pbase[e] = acc * 256 + pre[e]; acc += (t + 255) >> 8; if (u == 0) __hip_atomic_store(cnt + 64 * e, (unsigned)t, RLX_AGENT); } }
        __syncthreads();
        if (tid < 64) { int r1 = 0, r2 = 0;
            for (int t = 0; t < tid; ++t) { const int a = le[2 * t], b = le[2 * t + 1]; r1 += (a == info.x) + (b == info.x); r2 += (a == info.y) + (b == info.y); }
            const int s1 = pbase[info.x] + r1, s2 = pbase[info.y] + r2;
            tokslot[tok0 + tid] = (i32x2){s1, s2}; slotgate[s1] = __uint_as_float((unsigned)info.z); slotgate[s2] = __uint_as_float((unsigned)info.w);
            sl[2 * tid] = s1; sl[2 * tid + 1] = s2; }
        __syncthreads();
#pragma unroll 4
        for (int q = 0; q < 8; ++q) { const int tl = wave * 8 + q; const int s1 = sl[2 * tl], s2 = sl[2 * tl + 1];
            const GAS v4u* src = (const GAS v4u*)(hn + (size_t)(tok0 + tl) * D) + lane; const v4u a = src[0], b = src[64];
            GAS v4u* d1 = (GAS v4u*)(hp + (size_t)s1 * D) + lane; GAS v4u* d2 = (GAS v4u*)(hp + (size_t)s2 * D) + lane;
            d1[0] = a; d1[64] = b; d2[0] = a; d2[64] = b; }
        __syncthreads();
    }
}
__device__ __forceinline__ f32x4 y_frag(const bf16* y, const float* part, const float* slotgate, int slot, int j, int lane) {
    if ((slot >> 8) >= DNX_FULL) {
        const float* p = part + ((size_t)(((slot >> 8) - DNX_FULL) * (D / 256) + j) * DNX_NS) * 65536 + (size_t)(slot & 255) * 256 + 4 * lane;
        f32x4 s = *(const GAS f32x4*)p;
#pragma unroll
        for (int sl = 1; sl < DNX_NS; ++sl) s += *(const GAS f32x4*)(p + (size_t)sl * 65536);
        return s * slotgate[slot];
    }
    const u32x2 a = *((const GAS u32x2*)(y + (size_t)slot * D) + lane + 64 * j);
    return (f32x4){bf_lo(a.x), bf_hi(a.x), bf_lo(a.y), bf_hi(a.y)};
}
__device__ __forceinline__ void combine_phase(Frame& F, float* h, const float* gain, bf16* dst, float* fout) {
    int tid_l = F.tid; asm volatile("" : "+v"(tid_l)); const int tid = tid_l, lane = tid & 63, wave = __builtin_amdgcn_readfirstlane(tid >> 6); (void)tid; (void)lane; (void)wave;
    const int gw = F.vcu * NWAVES + wave, NGW = F.G * NWAVES;
    const bf16* y = (const bf16*)(F.ws + WS_Y); const i32x2* tokslot = (const i32x2*)(F.ws + WS_TOKSLOT);
    const float* part = (const float*)(F.ws + WS_PART); const float* slotgate = (const float*)(F.ws + WS_SLOTGATE);
    f32x4 g[4];
#pragma unroll
    for (int j = 0; j < 4; ++j) g[j] = *(const f32x4*)(gain + 4 * lane + 256 * j);
    for (int m = gw; m < M; m += NGW) {
        const i32x2 ss = tokslot[m]; const int s1 = __builtin_amdgcn_readfirstlane(ss.x), s2 = __builtin_amdgcn_readfirstlane(ss.y);
        GAS f32x4* xr = (GAS f32x4*)(h + (size_t)m * D) + lane;
        f32x4 v[4]; float s = 0.f;
#pragma unroll
        for (int j = 0; j < 4; ++j) { v[j] = xr[64 * j] + y_frag(y, part, slotgate, s1, j, lane) + y_frag(y, part, slotgate, s2, j, lane); s += dot4(v[j], v[j]); }
        const float rstd = 1.0f / sqrtf(wave_sum(s) * (1.f / D) + EPS);
        if (fout) { GAS f32x4* o = (GAS f32x4*)(fout + (size_t)m * D) + lane;
#pragma unroll
            for (int j = 0; j < 4; ++j) o[64 * j] = v[j] * rstd * g[j]; }
        else { GAS u32x2* o8 = (GAS u32x2*)(dst + (size_t)m * D) + lane;
#pragma unroll
            for (int j = 0; j < 4; ++j) { xr[64 * j] = v[j]; const f32x4 yv = v[j] * rstd * g[j]; u32x2 w; w.x = pkbf(yv.x, yv.y); w.y = pkbf(yv.z, yv.w); o8[64 * j] = w; } }
    }
}

struct Args { const float* in[28]; float* out; unsigned char* ws; int ph_lo, ph_hi; };
#define PG8_ALIGN true
#define PG8_SP2 true
__global__ void __launch_bounds__(NWAVES * 64, 2) trunk_fwd(Args args) {
    extern __shared__ __attribute__((aligned(16))) unsigned char lds[];
    Frame F;
    F.lds = (LAS unsigned char*)lds;
    F.MISC = (volatile LAS unsigned*)(F.lds + MISC_OFF);
    F.tid = threadIdx.x; F.lane = F.tid & 63; F.wave = __builtin_amdgcn_readfirstlane(F.tid >> 6);
    F.G = gridDim.x; { const int bx = blockIdx.x; F.vcu = (F.G % 8 == 0) ? (bx % 8) * (F.G / 8) + bx / 8 : bx; }
    F.ws = args.ws; F.out = args.out; F.in = nullptr;
    F.ctl = (gu32*)(args.ws + WS_CTL);
    for (int u = F.tid; u < (LDS_BYTES - LDSCTL_OFF) / 4; u += NWAVES * 64) ((LAS unsigned*)(F.lds + LDSCTL_OFF))[u] = 0u;
    __syncthreads();
    XcdBarrier bar = xcd_barrier_post((unsigned*)(F.ctl + CW_BAR), F.MISC + 8);
    const float* const* kargs = (const float* const*)__builtin_amdgcn_kernarg_segment_ptr();
#define INP(k) ({ const float* const* p_ = kargs; asm volatile("" : "+s"(p_)); p_[k]; })
    const int lo = args.ph_lo, hi = args.ph_hi;
    int ph = 0;
#ifndef PHMASK
#define PHMASK 0xffff
#endif
#define EN(k) (((PHMASK) >> (k)) & 1)
#define RUN() (lo <= ph && ph < hi)
#ifndef CONV_QUOTA
#define CONV_QUOTA 1
#endif
#define TAIL_PULL(nwg_) do { const int nw_ = (nwg_), c_ = (int)blockIdx.x; const int mine_ = c_ < nw_ ? (nw_ - 1 - c_) / F.G + 1 : 0, most_ = (nw_ + F.G - 1) / F.G; \
        if (mine_ < most_) conv_pull_block(F, kargs); } while (0)
#define SEAM() do { if (lo <= ph && ph + 1 < hi) { xcd_barrier(bar); if (PROBE_DUP & 16) { xcd_barrier(bar); xcd_barrier(bar); } } ++ph; } while (0)
    unsigned char* const ws = args.ws;
    float* const H = (float*)(ws + WS_H); bf16* const HN = (bf16*)(ws + WS_HN);

#ifndef PROBE_DUP
#define PROBE_DUP 0
#endif
    if (EN(0) && RUN()) { p0_prologue(F, kargs); if (PROBE_DUP & 1) p0_prologue(F, kargs); rms_phase(F, INP(0), INP(1), HN); }
    SEAM();

#pragma unroll 1
    for (int li = 0; li < 2; ++li) {
        unsigned char* const we = ws + WS_WE + (size_t)li * WE_STRIDE; unsigned char* const wo = ws + WS_WO + (size_t)li * WO_STRIDE;
        if (EN(1) && RUN()) { pg8::Gemm g{HN, (const bf16*)(we + WE_IN), M, INE, D, D}; pg8::StaticOrder S; S.init(M, INE, F.G, (int)blockIdx.x);
            pg8::EpiGeluSplit E{(bf16*)(ws + WS_PROJ), INE, 4};
            pg8::gemm_phase<pg8::EpiGeluSplit, pg8::StaticOrder, PG8_ALIGN, PG8_SP2>(F.lds + RING_OFF, g, S, E);
            TAIL_PULL(S.nwg); }
        SEAM();
        if (EN(2) && RUN()) { mixer_phase(F, li, INP(3), INP(5), INP(7)); if (PROBE_DUP & 2) mixer_phase(F, li, INP(3), INP(5), INP(7)); if (PROBE_DUP & 512) mixer_phase(F, li, INP(3), INP(5), INP(7), 0); if (PROBE_DUP & 1024) mixer_phase(F, li, INP(3), INP(5), INP(7), 1); }
        SEAM();
        if (EN(3) && RUN()) { pg8::Gemm g{(const bf16*)(ws + WS_MIX), (const bf16*)(we + WE_OUT), M, D, D, D}; pg8::StaticOrder S; S.init(M, D, F.G, (int)blockIdx.x);
            pg8::EpiRes E{li == 0 ? INP(0) : (const float*)H, H, D, nullptr};
            pg8::gemm_phase<pg8::EpiRes, pg8::StaticOrder, PG8_ALIGN, PG8_SP2>(F.lds + RING_OFF, g, S, E); }
        SEAM();
        if (EN(4) && RUN()) { rms_phase(F, H, INP(9) + li * D, HN); if (PROBE_DUP & 4) rms_phase(F, H, INP(9) + li * D, HN); }
        SEAM();
        if (EN(5) && RUN()) { pg8::Gemm g{HN, (const bf16*)(we + WE_GU), M, 2 * FFD, D, D}; pg8::StaticOrder S; S.init(M, 2 * FFD, F.G, (int)blockIdx.x);
            pg8::EpiGlu<0> E{(bf16*)(ws + WS_ACT), FFD, nullptr, nullptr};
            pg8::gemm_phase<pg8::EpiGlu<0>, pg8::StaticOrder, PG8_ALIGN, PG8_SP2>(F.lds + RING_OFF, g, S, E);
            if (PROBE_DUP & 32) { __syncthreads(); pg8::gemm_phase<pg8::EpiGlu<0>, pg8::StaticOrder, PG8_ALIGN, PG8_SP2>(F.lds + RING_OFF, g, S, E); }
            TAIL_PULL(S.nwg);
            if (PROBE_DUP & 64) { __syncthreads(); pg8::SameTileOrder S2; S2.nwg = S.nwg; S2.G = F.G; S2.c = (int)blockIdx.x; pg8::EpiGlu<0> E2{(bf16*)(ws + WS_Y), FFD, nullptr, nullptr};
                pg8::gemm_phase<pg8::EpiGlu<0>, pg8::SameTileOrder, PG8_ALIGN, PG8_SP2>(F.lds + RING_OFF, g, S2, E2); } }
        SEAM();
        if (EN(6) && RUN()) { pg8::Gemm g{(const bf16*)(ws + WS_ACT), (const bf16*)(we + WE_DN), M, D, FFD, FFD}; pg8::StaticOrder S; S.init(M, D, F.G, (int)blockIdx.x);
            pg8::EpiRes E{H, H, D, nullptr};
            pg8::gemm_phase<pg8::EpiRes, pg8::StaticOrder, PG8_ALIGN, PG8_SP2>(F.lds + RING_OFF, g, S, E); }
        SEAM();
        if (EN(7) && RUN()) rms_phase(F, H, INP(13) + li * D, HN);
        SEAM();
        if (EN(8) && RUN()) { pg8::Gemm g{HN, (const bf16*)(wo + WO_PW1), M, 2 * D, D, D}; pg8::StaticOrder S; S.init(M, 2 * D, F.G, (int)blockIdx.x);
            pg8::EpiGlu<1> E{(bf16*)(ws + WS_GLU), D, INP(15) + li * 2 * D, INP(15) + li * 2 * D + D};
            pg8::gemm_phase<pg8::EpiGlu<1>, pg8::StaticOrder, PG8_ALIGN, PG8_SP2>(F.lds + RING_OFF, g, S, E); }
        SEAM();
        if (EN(9) && RUN() && (PROBE_DUP & 8)) conv_phase(F, INP(16) + (size_t)li * CONVK * D, INP(17) + li * D, INP(18) + li * D, INP(19) + li * D);
        if (EN(9) && RUN()) conv_phase(F, INP(16) + (size_t)li * CONVK * D, INP(17) + li * D, INP(18) + li * D, INP(19) + li * D);
        SEAM();
        if (EN(10) && RUN()) { pg8::Gemm g{(const bf16*)(ws + WS_CV), (const bf16*)(wo + WO_PW2), M, D, D, D}; pg8::StaticOrder S; S.init(M, D, F.G, (int)blockIdx.x);
            pg8::EpiRes E{H, H, D, INP(21) + li * D};
            pg8::gemm_phase<pg8::EpiRes, pg8::StaticOrder, PG8_ALIGN, PG8_SP2>(F.lds + RING_OFF, g, S, E); }
        SEAM();
        gu32* const cnt = F.ctl + CW_MOE + li * 1024;
        if (EN(11) && RUN() && blockIdx.x == 0 && threadIdx.x == 0) __hip_atomic_store(F.ctl + CW_CONVSNAP + 64 * li, __hip_atomic_load(F.ctl + CW_CONVQ, RLX_AGENT), RLX_AGENT);
        if (EN(11) && RUN()) router_phase(F, H, INP(22) + li * D, INP(23) + (size_t)li * D * NEXP, HN);
        if (EN(11) && RUN() && (PROBE_DUP & 128)) { __syncthreads(); router_phase(F, H, INP(22) + li * D, INP(23) + (size_t)li * D * NEXP, HN); }
        SEAM();
        if (EN(12) && RUN()) { conv_drain(F, kargs, li); __syncthreads(); scatter_phase(F, cnt); if (PROBE_DUP & 256) { __syncthreads(); scatter_phase(F, cnt); } }
        SEAM();
        if (EN(13) && RUN()) { pg8::GroupedOrder S; { int acc = 0; S.ts[0] = 0;
#pragma unroll
                for (int e = 0; e < NEXP; ++e) { const int c = __builtin_amdgcn_readfirstlane((int)__hip_atomic_load(cnt + 64 * e, RLX_AGENT)); acc += (c + 255) >> 8; S.ts[e + 1] = acc; }
                S.nM = acc; S.nN = 2 * FFX / 256; S.nwg = acc * S.nN; S.G = F.G; S.c = (int)blockIdx.x; }
            pg8::Gemm g{(const bf16*)(ws + WS_HP), (const bf16*)(wo + WO_GUX), MSLOT, 2 * FFX, D, D};
            pg8::EpiGlu<0> E{(bf16*)(ws + WS_ACTX), FFX, nullptr, nullptr};
            pg8::gemm_phase<pg8::EpiGlu<0>, pg8::GroupedOrder, PG8_ALIGN, PG8_SP2>(F.lds + RING_OFF, g, S, E);
            TAIL_PULL(S.nwg); }
        SEAM();
        if (EN(14) && RUN()) { int tsv[9]; int acc = 0; tsv[0] = 0;
#pragma unroll
            for (int e = 0; e < NEXP; ++e) { const int c = __builtin_amdgcn_readfirstlane((int)__hip_atomic_load(cnt + 64 * e, RLX_AGENT)); acc += (c + 255) >> 8; tsv[e + 1] = acc; }
            const int nfull = acc < DNX_FULL ? acc : DNX_FULL;
            { pg8::GroupedOrder S;
#pragma unroll
              for (int e = 0; e < 9; ++e) S.ts[e] = tsv[e];
              S.nM = nfull; S.nN = D / 256; S.nwg = nfull * S.nN; S.G = F.G; S.c = (int)blockIdx.x;
              pg8::Gemm g{(const bf16*)(ws + WS_ACTX), (const bf16*)(wo + WO_DNX), MSLOT, D, FFX, FFX};
              pg8::EpiScale E{(bf16*)(ws + WS_Y), D, (const float*)(ws + WS_SLOTGATE)};
              pg8::gemm_phase<pg8::EpiScale, pg8::GroupedOrder, PG8_ALIGN, PG8_SP2>(F.lds + RING_OFF, g, S, E); }
            __syncthreads();
            { pg8::SplitOrder S;
#pragma unroll
              for (int e = 0; e < 9; ++e) S.ts[e] = tsv[e];
              S.pm0 = DNX_FULL; S.R = acc - nfull; S.nN = D / 256; S.NS = DNX_NS; S.KS = DNX_KS; S.nwg = S.R * S.nN * DNX_NS; S.G = F.G; S.c = (int)blockIdx.x;
              pg8::Gemm g{(const bf16*)(ws + WS_ACTX), (const bf16*)(wo + WO_DNX), MSLOT, D, DNX_KS, FFX};
              pg8::EpiPart E{(float*)(ws + WS_PART), DNX_FULL, D / 256, DNX_NS, DNX_KS};
              pg8::gemm_phase<pg8::EpiPart, pg8::SplitOrder, PG8_ALIGN, PG8_SP2>(F.lds + RING_OFF, g, S, E); } }
        SEAM();
        if (EN(15) && RUN()) combine_phase(F, H, li == 0 ? INP(1) + D : INP(27), HN, li == 0 ? nullptr : args.out);
        SEAM();
    }
#undef RUN
#undef SEAM
}

extern "C" void kernel_launch(void* const* d_in, const int* in_sizes, int n_in, void* d_out, int out_size, void* d_ws, size_t ws_size, hipStream_t stream) {
    static int grid = 0;
    if (grid == 0) {
        if (n_in != 28 || in_sizes[0] != M * D || out_size != M * D || ws_size < WS_END) { fprintf(stderr, "kernel_launch: shape/workspace mismatch (n_in %d, in0 %d, out %d, ws %zu, need %zu); nothing launched\n", n_in, n_in > 0 ? in_sizes[0] : -1, out_size, ws_size, (size_t)WS_END); grid = -1; return; }
        int dev = 0, cus = 0, per_cu = 0;
        if (hipGetDevice(&dev) != hipSuccess || hipDeviceGetAttribute(&cus, hipDeviceAttributeMultiprocessorCount, dev) != hipSuccess) { grid = -1; return; }
        if (hipFuncSetAttribute((const void*)trunk_fwd, hipFuncAttributeMaxDynamicSharedMemorySize, LDS_BYTES) != hipSuccess) { fprintf(stderr, "kernel_launch: hipFuncSetAttribute failed\n"); grid = -1; return; }
        if (hipOccupancyMaxActiveBlocksPerMultiprocessor(&per_cu, (const void*)trunk_fwd, NWAVES * 64, LDS_BYTES) != hipSuccess || per_cu < 1)
            fprintf(stderr, "kernel_launch: note: occupancy query reports %d workgroups per CU\n", per_cu);
        (void)hipGetLastError();
        grid = cus;
    }
    if (grid < 0) return;
    if (hipMemsetAsync((char*)d_ws + WS_CTL, 0, CTL_ZERO_BYTES, stream) != hipSuccess) { fprintf(stderr, "kernel_launch: hipMemsetAsync failed\n"); return; }
    Args a{};
    for (int i = 0; i < 28; ++i) a.in[i] = (const float*)d_in[i];
    a.out = (float*)d_out; a.ws = (unsigned char*)d_ws;
#if MK_PER_PHASE
    for (int p = 0; p < NPH; ++p) { a.ph_lo = p; a.ph_hi = p + 1; hipLaunchKernelGGL(trunk_fwd, dim3(grid), dim3(NWAVES * 64), LDS_BYTES, stream, a); }
#else
    a.ph_lo = 0; a.ph_hi = NPH;
    hipLaunchKernelGGL(trunk_fwd, dim3(grid), dim3(NWAVES * 64), LDS_BYTES, stream, a);
#endif
    const hipError_t le = hipPeekAtLastError();
    if (le != hipSuccess) fprintf(stderr, "kernel_launch: launch failed: %s\n", hipGetErrorName(le));
}
```
